# Optimizing an MI355X kernel written in HIP

```python
import jax, jax.numpy as jnp
from jax import lax
import numpy as np

D_MODEL = 1024
BATCH = 2
SEQ = 16384
DEPTH = 4

CHUNK = 64
LEFT_CHUNKS = 8
BAND = (LEFT_CHUNKS + 1) * CHUNK
ATT_HEAD_DIM = 64
ATT_HEADS = D_MODEL // 128
ATT_WIDTH = ATT_HEADS * ATT_HEAD_DIM
REL_CLIP = 128
CONV_CH = D_MODEL // 4
CONV_K = 3
SG_WIDTH = D_MODEL // 4
SG_GROUPS = 4
SG_GROUP_DIM = SG_WIDTH // SG_GROUPS
SG_BLOCK = 128
GROUP_DIM = 64
MIX_WIDTH = ATT_WIDTH + CONV_CH + SG_WIDTH
N_GROUPS = MIX_WIDTH // GROUP_DIM
IN_WIDTH = 3 * ATT_WIDTH + 3 * CONV_CH + 2 * SG_WIDTH
D_FF = 4 * D_MODEL
EPS = 1e-6

kernel_name = "hybrid_chunk_attn_gconv_gmlp_trunk"


def rms_norm(x, g):
    xf = x.astype(jnp.float32)
    y = xf * lax.rsqrt(jnp.mean(xf * xf, axis=-1, keepdims=True) + EPS)
    return (y * g.astype(jnp.float32)).astype(x.dtype)


def layer_norm(x, g, b):
    xf = x.astype(jnp.float32)
    mu = jnp.mean(xf, axis=-1, keepdims=True)
    var = jnp.mean(jnp.square(xf - mu), axis=-1, keepdims=True)
    y = (xf - mu) * lax.rsqrt(var + EPS)
    return (y * g.astype(jnp.float32) + b.astype(jnp.float32)).astype(x.dtype)


def chunked_rel_attention(q, k, v, rel_bias):
    b, s, h, dh = q.shape
    n_c = s // CHUNK
    qc = q.reshape(b, n_c, CHUNK, h, dh)
    pad = ((0, 0), (LEFT_CHUNKS, 0), (0, 0), (0, 0), (0, 0))
    kp = jnp.pad(k.reshape(b, n_c, CHUNK, h, dh), pad)
    vp = jnp.pad(v.reshape(b, n_c, CHUNK, h, dh), pad)
    kb = jnp.stack([kp[:, j:j + n_c] for j in range(LEFT_CHUNKS + 1)], axis=2).reshape(b, n_c, BAND, h, dh)
    vb = jnp.stack([vp[:, j:j + n_c] for j in range(LEFT_CHUNKS + 1)], axis=2).reshape(b, n_c, BAND, h, dh)
    rel = jnp.arange(CHUNK)[:, None] + LEFT_CHUNKS * CHUNK - jnp.arange(BAND)[None, :]
    idx = jnp.clip(rel, -REL_CLIP, REL_CLIP) + REL_CLIP
    bias = rel_bias.astype(jnp.float32)[:, idx]
    key_chunk = jnp.arange(n_c)[:, None] - LEFT_CHUNKS + jnp.arange(BAND)[None, :] // CHUNK
    valid = key_chunk >= 0
    scores = jnp.einsum('bnqhd,bnkhd->bnhqk', qc, kb).astype(jnp.float32) * (dh ** -0.5)
    scores = scores + bias[None, None]
    scores = jnp.where(valid[None, :, None, None, :], scores, jnp.float32(-1e30))
    p = jax.nn.softmax(scores, axis=-1).astype(v.dtype)
    out = jnp.einsum('bnhqk,bnkhd->bnqhd', p, vb)
    return out.reshape(b, s, h * dh)


def gated_short_conv(bg, cg, xh, conv_w):
    z = cg * xh
    s = z.shape[1]
    zp = jnp.pad(z, ((0, 0), (CONV_K - 1, 0), (0, 0)))
    y = sum(zp[:, j:j + s] * conv_w[j] for j in range(CONV_K))
    return bg * y


def spatial_gating(u, v, ln_g, ln_b, sg_w, sg_b):
    b, s, _ = u.shape
    u = jax.nn.gelu(u, approximate=False)
    v = layer_norm(jax.nn.gelu(v, approximate=False), ln_g, ln_b)
    vb = v.reshape(b, s // SG_BLOCK, SG_BLOCK, SG_GROUPS, SG_GROUP_DIM)
    mask = jnp.tril(jnp.ones((SG_BLOCK, SG_BLOCK), dtype=sg_w.dtype))
    ws = sg_w * mask[None]
    mixed = jnp.einsum('gts,bnsgc->bntgc', ws, vb) + sg_b.T[None, None, :, :, None]
    return u * mixed.reshape(b, s, SG_WIDTH)


def setup_inputs(seed: int = 0) -> dict:
    key = jax.random.key(seed)
    ks = jax.random.split(key, 16)
    f32 = jnp.float32
    nrm = lambda k, shp, sc: jax.random.normal(k, shp, f32) * sc
    return {
        "x": nrm(ks[0], (BATCH, SEQ, D_MODEL), 1.0),
        "mix_norm_g": 1.0 + nrm(ks[1], (DEPTH, D_MODEL), 0.02),
        "w_in": nrm(ks[2], (DEPTH, D_MODEL, IN_WIDTH), D_MODEL ** -0.5),
        "rel_bias": nrm(ks[3], (DEPTH, ATT_HEADS, 2 * REL_CLIP + 1), 0.1),
        "conv_w": nrm(ks[4], (DEPTH, CONV_K, CONV_CH), CONV_K ** -0.5),
        "sg_ln_g": 1.0 + nrm(ks[5], (DEPTH, SG_WIDTH), 0.02),
        "sg_ln_b": nrm(ks[6], (DEPTH, SG_WIDTH), 0.02),
        "sg_w": nrm(ks[7], (DEPTH, SG_GROUPS, SG_BLOCK, SG_BLOCK), 0.5 * SG_BLOCK ** -0.5),
        "sg_b": 1.0 + nrm(ks[8], (DEPTH, SG_GROUPS, SG_BLOCK), 0.02),
        "group_norm_g": 1.0 + nrm(ks[9], (DEPTH, MIX_WIDTH), 0.02),
        "w_out": nrm(ks[10], (DEPTH, MIX_WIDTH, D_MODEL), 0.5 * MIX_WIDTH ** -0.5),
        "mlp_norm_g": 1.0 + nrm(ks[11], (DEPTH, D_MODEL), 0.02),
        "w_up": nrm(ks[12], (DEPTH, D_MODEL, D_FF), D_MODEL ** -0.5),
        "w_down": nrm(ks[13], (DEPTH, D_FF, D_MODEL), 0.5 * D_FF ** -0.5),
        "final_norm_g": 1.0 + nrm(ks[14], (D_MODEL,), 0.02),
    }


def reference(x, mix_norm_g, w_in, rel_bias, conv_w, sg_ln_g, sg_ln_b, sg_w, sg_b,
              group_norm_g, w_out, mlp_norm_g, w_up, w_down, final_norm_g):
    b, s, _ = x.shape
    cuts = np.cumsum([ATT_WIDTH, ATT_WIDTH, ATT_WIDTH, CONV_CH, CONV_CH, CONV_CH, SG_WIDTH])
    for l in range(DEPTH):
        n = rms_norm(x, mix_norm_g[l])
        proj = jnp.einsum('bsd,de->bse', n, w_in[l])
        q, k, v, bg, cg, xh, su, sv = jnp.split(proj, cuts, axis=-1)
        shp = (b, s, ATT_HEADS, ATT_HEAD_DIM)
        y_a = chunked_rel_attention(q.reshape(shp), k.reshape(shp), v.reshape(shp), rel_bias[l])
        y_b = gated_short_conv(bg, cg, xh, conv_w[l])
        y_c = spatial_gating(su, sv, sg_ln_g[l], sg_ln_b[l], sg_w[l], sg_b[l])
        mixed = jnp.concatenate([y_a, y_b, y_c], axis=-1)
        g = group_norm_g[l].reshape(N_GROUPS, GROUP_DIM)
        mixed = rms_norm(mixed.reshape(b, s, N_GROUPS, GROUP_DIM), g).reshape(b, s, MIX_WIDTH)
        x = x + jnp.einsum('bse,ed->bsd', mixed, w_out[l])
        hdn = jnp.einsum('bsd,df->bsf', rms_norm(x, mlp_norm_g[l]), w_up[l])
        hdn = jnp.square(jax.nn.relu(hdn))
        x = x + jnp.einsum('bsf,fd->bsd', hdn, w_down[l])
    return rms_norm(x, final_norm_g)
```

```cpp
#include <hip/hip_runtime.h>
#include <hip/hip_cooperative_groups.h>
#include <cstdio>
#include <cstdint>
namespace cg = cooperative_groups;
namespace pg8 {
#define PG8_LAS __attribute__((address_space(3)))
typedef unsigned short bf16_t;
typedef short bf16x8 __attribute__((ext_vector_type(8)));
typedef float f32x4 __attribute__((ext_vector_type(4)));
typedef unsigned u32x4 __attribute__((ext_vector_type(4)));
constexpr int BM = 256, BK = 64, HALF = 128, HTB = HALF * BK * 2  , STAGE_BYTES = 8 * HTB, NXCD = 8, WGM = 8;

__host__ __device__ __forceinline__ int lds_byte(int r, int c) { const int st = (r >> 4) * 2 + (c >> 5), rr = r & 15, cc = c & 31, ob = rr * 64 + cc * 2; return st * 1024 + (ob ^ (((ob >> 9) & 1) << 5)); }
__host__ __device__ __forceinline__ void stage_rc(int b, int& R, int& C) { const int st = b / 1024, sb = b % 1024, swz = sb ^ (((sb >> 9) & 1) << 5); R = (st >> 1) * 16 + swz / 64; C = (st & 1) * 32 + (swz % 64) / 2; }
__host__ __device__ __forceinline__ int perm32(int rho) { const int n = rho >> 4, i = rho & 15; return 8 * (i >> 2) + 4 * n + (i & 3); }

struct Unit { int pm, pn; };
struct Gemm { const bf16_t* A; const bf16_t* Bt; int M, N, K; };

struct StaticOrder {
    int nM, nN, nwg, G, c;
    __host__ __device__ void init(int M, int N, int G_, int c_) { nM = M / BM; nN = N / BM; nwg = nM * nN; G = G_; c = c_; }
    __host__ __device__ bool next(int i, Unit& u) const {
        const long L = (long)i * G + c; if (L >= nwg) return false;
        int wgid = (int)L; { const int q = nwg / NXCD, r = nwg % NXCD, xcd = wgid % NXCD, off = wgid / NXCD; wgid = (xcd < r ? xcd * (q + 1) : r * (q + 1) + (xcd - r) * q) + off; }
        const int nig = WGM * nN, gid = wgid / nig, fm = gid * WGM, gsz = (nM - fm) < WGM ? (nM - fm) : WGM;
        u.pm = fm + ((wgid % nig) % gsz); u.pn = (wgid % nig) / gsz; return true;
    }
    __device__ __forceinline__ void a_ready(const Unit&) const {}
    __device__ __forceinline__ void done(const Unit&) const {}
};

__device__ __forceinline__ unsigned cvt_pk_bf16(float lo, float hi) { unsigned r; asm volatile("v_cvt_pk_bf16_f32 %0, %1, %2" : "=v"(r) : "v"(lo), "v"(hi)); return r; }
typedef float f32x2 __attribute__((ext_vector_type(2)));
__device__ __forceinline__ f32x2 gelu_pk(f32x2 v) {
    const f32x2 av = __builtin_elementwise_abs(v), d = av * 0.2316418882f + 1.0f;
    f32x2 t; t.x = __builtin_amdgcn_rcpf(d.x); t.y = __builtin_amdgcn_rcpf(d.y);
    f32x2 q = t * 0.5307027145f + (-0.7265760135f); q = q * t + 0.7107068705f; q = q * t + (-0.142248368f); q = q * t + 0.127414796f; q = q * t;
    const f32x2 s = (v * v) * (-0.72134752044f);
    f32x2 e; e.x = __builtin_amdgcn_exp2f(s.x); e.y = __builtin_amdgcn_exp2f(s.y);
    const f32x2 m = v * (q * e), r = v - m;
    f32x2 o; o.x = v.x < 0.f ? m.x : r.x; o.y = v.y < 0.f ? m.y : r.y; return o;
}


typedef unsigned u32x2 __attribute__((ext_vector_type(2)));
typedef __bf16 bf16x2_t __attribute__((ext_vector_type(2)));
__device__ __forceinline__ unsigned cvtpk(float lo, float hi) { f32x2 v = {lo, hi}; bf16x2_t b = __builtin_convertvector(v, bf16x2_t); return __builtin_bit_cast(unsigned, b); }
constexpr float RMS_EPS = 1e-6f;
__device__ __forceinline__ float row_rstd(const char* rec) {
    const f32x4* p = (const f32x4*)rec;
    const f32x4 a = p[0], b = p[1], c = p[2], d = p[3];
    const f32x4 s = (a + b) + (c + d);
    const float t = (s[0] + s[1]) + (s[2] + s[3]);
    return __builtin_amdgcn_rsqf(t * (1.0f / 1024.0f) + RMS_EPS);
}
template <int MODE, int LDC> struct EpiAct {
    static constexpr bool PERM = true, AFTER_DRAIN = false;
    bf16_t* O; const float* ss; float qscale;
    __device__ __forceinline__ void operator()(const f32x4 (&acc)[2][2][4][2], const Unit& u, int wr, int wc, int fr, int fq) const {
        const int rl = wr * 64 + fr;
        unsigned ooff = (unsigned)(rl * LDC + wc * 32 + 8 * fq) * 2u, soff = (unsigned)rl * 64u;
        asm volatile("" : "+v"(ooff), "+v"(soff));
        char* obase = (char*)O + ((size_t)u.pm * BM * LDC + (size_t)u.pn * BM) * 2;
        const char* sbase = (const char*)ss + (size_t)u.pm * BM * 64;
        const float sc = (MODE == 0 && u.pn < 2) ? qscale : 1.0f; const bool act = (MODE == 0 && u.pn >= 9);
#pragma unroll
        for (int ai = 0; ai < 2; ++ai)
#pragma unroll
            for (int m = 0; m < 4; ++m) { const int ro = ai * HALF + m * 16; const float rs = row_rstd(sbase + soff + ro * 64) * sc; char* rowp = obase + ooff + (size_t)ro * LDC * 2;
#pragma unroll
                for (int bj = 0; bj < 2; ++bj) { f32x4 v0 = acc[ai][bj][m][0] * rs, v1 = acc[ai][bj][m][1] * rs;
                    if (MODE == 0) { if (act) { f32x2 a = gelu_pk((f32x2){v0[0], v0[1]}), b = gelu_pk((f32x2){v0[2], v0[3]}), c = gelu_pk((f32x2){v1[0], v1[1]}), d = gelu_pk((f32x2){v1[2], v1[3]});
                        v0 = (f32x4){a.x, a.y, b.x, b.y}; v1 = (f32x4){c.x, c.y, d.x, d.y}; } }
                    else { v0 = __builtin_elementwise_max(v0, (f32x4){0.f, 0.f, 0.f, 0.f}); v1 = __builtin_elementwise_max(v1, (f32x4){0.f, 0.f, 0.f, 0.f}); v0 = v0 * v0; v1 = v1 * v1; }
                    u32x4 w; w.x = cvtpk(v0[0], v0[1]); w.y = cvtpk(v0[2], v0[3]); w.z = cvtpk(v1[0], v1[1]); w.w = cvtpk(v1[2], v1[3]);
                    *(u32x4*)(rowp + bj * HALF * 2) = w; } }
    }
};
struct EpiRes {
    static constexpr bool PERM = false, AFTER_DRAIN = false;
    const float* base; float* out; bf16_t* xb; float* ss;
    __device__ __forceinline__ void operator()(const f32x4 (&acc)[2][2][4][2], const Unit& u, int wr, int wc, int fr, int fq) const {
        const int rl = wr * 64 + fr;
        unsigned eoff = (unsigned)(rl * 1024 + wc * 32 + 4 * fq), soff = (unsigned)(rl * 16 + wc) * 4u;
        asm volatile("" : "+v"(eoff), "+v"(soff));
        const size_t tile = (size_t)u.pm * BM * 1024 + (size_t)u.pn * BM;
        const char* bbase = (const char*)(base + tile); char* obase = (char*)(out + tile); char* xbase = (char*)(xb + tile);
        char* sbase = (char*)ss + (size_t)u.pm * BM * 64 + u.pn * 16;
#pragma unroll
        for (int ai = 0; ai < 2; ++ai)
#pragma unroll
            for (int m = 0; m < 4; ++m) { const int ro = ai * HALF + m * 16; float q = 0.f;
#pragma unroll
                for (int bj = 0; bj < 2; ++bj)
#pragma unroll
                    for (int n = 0; n < 2; ++n) { const unsigned e = eoff + ro * 1024 + bj * HALF + n * 16;
                        const f32x4 b = *(const f32x4*)(bbase + (size_t)e * 4); const f32x4 o = b + acc[ai][bj][m][n];
                        *(f32x4*)(obase + (size_t)e * 4) = o; u32x2 w; w.x = cvtpk(o[0], o[1]); w.y = cvtpk(o[2], o[3]); *(u32x2*)(xbase + (size_t)e * 2) = w;
                        q += (o[0] * o[0] + o[1] * o[1]) + (o[2] * o[2] + o[3] * o[3]); }
                q += __shfl_xor(q, 16); q += __shfl_xor(q, 32);
                if (fq == 0) *(float*)(sbase + soff + ro * 64) = q; }
    }
};
template <class Epi, class Sched, bool ALIGN_EPI = false, bool SP2 = false>
__device__ __forceinline__ void gemm_phase(PG8_LAS unsigned char* lds, const Gemm g, const Sched& S, const Epi& E) {
    int tid_ = threadIdx.x; asm volatile("" : "+v"(tid_));
    const int tid = tid_, wid = __builtin_amdgcn_readfirstlane(tid >> 6), lane = tid & 63, wr = wid >> 2, wc = wid & 3, fr = lane & 15, fq = lane >> 4;
    const int K = g.K, nt = K / BK;
    unsigned voffA[2], voffB[2];
#pragma unroll
    for (int i = 0; i < 2; ++i) { int R, C; stage_rc(tid * 16 + i * 8192, R, C); const int Rb = Epi::PERM ? ((R & ~31) + perm32(R & 31)) : R;
        voffA[i] = (unsigned)(R * K + C) * 2u; voffB[i] = (unsigned)(Rb * K + C) * 2u; }
    const size_t kstep = (size_t)(BK * 2);
    const size_t hstep = (size_t)HALF * K * 2;
    const size_t tstep = 2 * hstep;
    const unsigned ldsw = (unsigned)wid * 1024u;
    const int aoff = lds_byte(wr * 64 + fr, fq * 8), boff = lds_byte(wc * 32 + fr, fq * 8);
#define PG8_SA(b, h) (((b) * 2 + (h)) * HTB)
#define PG8_SB(b, h) ((4 + (b) * 2 + (h)) * HTB)
#define PG8_STAGE(bufoff, gbase, voff) do { _Pragma("unroll") for (int _i = 0; _i < 2; ++_i) \
        __builtin_amdgcn_global_load_lds((const unsigned*)((const char*)(gbase) + (voff)[_i]), (PG8_LAS unsigned*)(lds + (bufoff) + ldsw + _i * 8192), 16, 0, 0); } while (0)
#define PG8_LDA(dst, b, h) do { _Pragma("unroll") for (int m = 0; m < 4; ++m) _Pragma("unroll") for (int k = 0; k < 2; ++k) dst[m][k] = *(const PG8_LAS bf16x8*)(lds + PG8_SA(b, h) + aoff + m * 2048 + k * 1024); } while (0)
#define PG8_LDB(dst, b, h) do { _Pragma("unroll") for (int n = 0; n < 2; ++n) _Pragma("unroll") for (int k = 0; k < 2; ++k) dst[n][k] = *(const PG8_LAS bf16x8*)(lds + PG8_SB(b, h) + boff + n * 2048 + k * 1024); } while (0)
#define PG8_MMA(ai, bj, At, Bt) do { __builtin_amdgcn_s_setprio(1); _Pragma("unroll") for (int m = 0; m < 4; ++m) _Pragma("unroll") for (int n = 0; n < 2; ++n) _Pragma("unroll") for (int k = 0; k < 2; ++k) \
        acc[ai][bj][m][n] = __builtin_amdgcn_mfma_f32_16x16x32_bf16(Bt[n][k], At[m][k], acc[ai][bj][m][n], 0, 0, 0); __builtin_amdgcn_s_setprio(0); } while (0)
#define PG8_WAIT_V(n) asm volatile("s_waitcnt vmcnt(" #n ")" ::: "memory")
#define PG8_WAIT_L(n) asm volatile("s_waitcnt lgkmcnt(" #n ")" ::: "memory")
#define PG8_BAR __builtin_amdgcn_s_barrier()
#define PG8_SCHED __builtin_amdgcn_sched_barrier(0)
    Unit cur, nxt; int ui = 0;
    if (!S.next(0, cur)) return;
    f32x4 acc[2][2][4][2];
#pragma unroll
    for (int a = 0; a < 2; ++a)
#pragma unroll
        for (int b = 0; b < 2; ++b)
#pragma unroll
            for (int m = 0; m < 4; ++m)
#pragma unroll
                for (int n = 0; n < 2; ++n) acc[a][b][m][n] = (f32x4){0.f, 0.f, 0.f, 0.f};
    bf16x8 At[4][2], B0[2][2], B1[2][2];
    const char* cA = (const char*)g.A + (size_t)cur.pm * tstep; const char* cB = (const char*)g.Bt + (size_t)cur.pn * tstep;
    S.a_ready(cur);
    if constexpr (SP2) {
        PG8_STAGE(PG8_SB(0, 0), cB, voffB); PG8_STAGE(PG8_SB(0, 1), cB + hstep, voffB); PG8_STAGE(PG8_SA(0, 0), cA, voffA); PG8_STAGE(PG8_SA(0, 1), cA + hstep, voffA);
        if (wr == 1) PG8_BAR;
        PG8_WAIT_V(2); PG8_BAR;
        PG8_STAGE(PG8_SB(1, 0), cB + kstep, voffB); PG8_STAGE(PG8_SA(1, 0), cA + kstep, voffA); PG8_STAGE(PG8_SB(1, 1), cB + hstep + kstep, voffB);
        PG8_WAIT_V(6); PG8_BAR;
    } else {
        PG8_STAGE(PG8_SB(0, 0), cB, voffB); PG8_STAGE(PG8_SA(0, 0), cA, voffA); PG8_STAGE(PG8_SB(0, 1), cB + hstep, voffB); PG8_STAGE(PG8_SA(0, 1), cA + hstep, voffA);
        if (wr == 1) PG8_BAR;
        PG8_WAIT_V(4); PG8_BAR;
        PG8_STAGE(PG8_SB(1, 0), cB + kstep, voffB); PG8_STAGE(PG8_SA(1, 0), cA + kstep, voffA); PG8_STAGE(PG8_SB(1, 1), cB + hstep + kstep, voffB);
        PG8_WAIT_V(6); PG8_BAR;
    }
    for (;;) {
        const bool has_next = S.next(ui + 1, nxt);
        const char* nA = has_next ? (const char*)g.A + (size_t)nxt.pm * tstep : cA; const char* nB = has_next ? (const char*)g.Bt + (size_t)nxt.pn * tstep : cB;
        for (int t = 0; t < nt; t += 2) {
            const bool last = (t == nt - 2);
            const char* a1 = cA + (size_t)(t + 1) * kstep;
            const char* a2 = last ? nA : cA + (size_t)(t + 2) * kstep; const char* b2 = last ? nB : cB + (size_t)(t + 2) * kstep;
            const char* a3 = a2 + kstep; const char* b3 = b2 + kstep;
            if (last && has_next) S.a_ready(nxt);
            if constexpr (SP2) {
            PG8_LDB(B0, 0, 0); PG8_LDB(B1, 0, 1); PG8_SCHED; PG8_LDA(At, 0, 0); PG8_STAGE(PG8_SA(1, 1), a1 + hstep, voffA);
            PG8_WAIT_V(8); PG8_WAIT_L(0); PG8_BAR; PG8_MMA(0, 0, At, B0); PG8_MMA(0, 1, At, B1); PG8_BAR; PG8_SCHED;
            PG8_LDA(At, 0, 1); PG8_STAGE(PG8_SB(0, 0), b2, voffB); PG8_STAGE(PG8_SB(0, 1), b2 + hstep, voffB); PG8_STAGE(PG8_SA(0, 0), a2, voffA);
            PG8_WAIT_V(8); PG8_WAIT_L(0); PG8_BAR; PG8_MMA(1, 0, At, B0); PG8_MMA(1, 1, At, B1); PG8_BAR; PG8_SCHED;
            PG8_LDB(B0, 1, 0); PG8_LDB(B1, 1, 1); PG8_SCHED; PG8_LDA(At, 1, 0); PG8_STAGE(PG8_SA(0, 1), a2 + hstep, voffA);
            PG8_WAIT_V(8); PG8_WAIT_L(0); PG8_BAR; PG8_MMA(0, 0, At, B0); PG8_MMA(0, 1, At, B1); PG8_BAR; PG8_SCHED;
            PG8_LDA(At, 1, 1); PG8_STAGE(PG8_SB(1, 0), b3, voffB); PG8_STAGE(PG8_SB(1, 1), b3 + hstep, voffB); PG8_STAGE(PG8_SA(1, 0), a3, voffA);
            PG8_WAIT_V(8); PG8_WAIT_L(0); PG8_BAR; PG8_MMA(1, 0, At, B0); PG8_MMA(1, 1, At, B1); PG8_BAR; PG8_SCHED;
            } else {
            PG8_LDB(B0, 0, 0); PG8_SCHED; PG8_LDA(At, 0, 0); PG8_STAGE(PG8_SA(1, 1), a1 + hstep, voffA);
            PG8_WAIT_L(8); PG8_BAR; PG8_WAIT_L(0); PG8_MMA(0, 0, At, B0); PG8_BAR; PG8_SCHED;
            PG8_LDB(B1, 0, 1); PG8_STAGE(PG8_SB(0, 0), b2, voffB);
            PG8_BAR; PG8_WAIT_L(0); PG8_MMA(0, 1, At, B1); PG8_BAR;
            PG8_LDA(At, 0, 1); PG8_STAGE(PG8_SA(0, 0), a2, voffA);
            PG8_BAR; PG8_WAIT_L(0); PG8_MMA(1, 0, At, B0); PG8_BAR; PG8_SCHED;
            PG8_STAGE(PG8_SB(0, 1), b2 + hstep, voffB);
            PG8_WAIT_V(6); PG8_BAR; PG8_MMA(1, 1, At, B1); PG8_BAR;
            PG8_LDB(B0, 1, 0); PG8_SCHED; PG8_LDA(At, 1, 0); PG8_STAGE(PG8_SA(0, 1), a2 + hstep, voffA);
            PG8_WAIT_L(8); PG8_BAR; PG8_WAIT_L(0); PG8_MMA(0, 0, At, B0); PG8_BAR; PG8_SCHED;
            PG8_LDB(B1, 1, 1); PG8_STAGE(PG8_SB(1, 0), b3, voffB);
            PG8_BAR; PG8_WAIT_L(0); PG8_MMA(0, 1, At, B1); PG8_BAR;
            PG8_LDA(At, 1, 1); PG8_STAGE(PG8_SA(1, 0), a3, voffA);
            PG8_BAR; PG8_WAIT_L(0); PG8_MMA(1, 0, At, B0); PG8_BAR; PG8_SCHED;
            PG8_STAGE(PG8_SB(1, 1), b3 + hstep, voffB);
            PG8_WAIT_V(6); PG8_BAR; PG8_MMA(1, 1, At, B1); PG8_BAR;
            }
        }
        if constexpr (ALIGN_EPI) { if (wr == 0) PG8_BAR; }
        if constexpr (!Epi::AFTER_DRAIN) { E(acc, cur, wr, wc, fr, fq); S.done(cur); }
        if (!has_next) break;
#pragma unroll
        for (int a = 0; a < 2; ++a)
#pragma unroll
            for (int b = 0; b < 2; ++b)
#pragma unroll
                for (int m = 0; m < 4; ++m)
#pragma unroll
                    for (int n = 0; n < 2; ++n) acc[a][b][m][n] = (f32x4){0.f, 0.f, 0.f, 0.f};
        cur = nxt; cA = nA; cB = nB; ++ui;
        if constexpr (ALIGN_EPI) { if (wr == 1) PG8_BAR; }
    }
    PG8_WAIT_V(0);
    if constexpr (!ALIGN_EPI) { if (wr == 0) PG8_BAR; }
    PG8_BAR;
    if constexpr (Epi::AFTER_DRAIN) { E.fused(acc, cur, wr, wc, fr, fq, lds, wid, lane); S.done(cur); }
#undef PG8_SA
#undef PG8_SB
#undef PG8_STAGE
#undef PG8_LDA
#undef PG8_LDB
#undef PG8_MMA
#undef PG8_WAIT_V
#undef PG8_WAIT_L
#undef PG8_BAR
#undef PG8_SCHED
}
}

constexpr int BATCH = 2, SEQ = 16384, DM = 1024, DEPTH = 4, M_TOK = BATCH * SEQ;
constexpr int PW = 2816;
constexpr int COL_K = 512, COL_V = 1024, COL_BG = 1536, COL_CG = 1792, COL_XH = 2048, COL_SU = 2304, COL_SV = 2560;
constexpr int DFF = 4096, NCHUNK = SEQ / 64;
constexpr float LOG2E = 1.4426950408889634f;
constexpr float QSCALE = 0.125f * LOG2E;
constexpr float EPS = 1e-6f;

#define LAS __attribute__((address_space(3)))
typedef unsigned short bf16;
typedef short bf16x8 __attribute__((ext_vector_type(8)));
typedef short s16x4 __attribute__((ext_vector_type(4)));
typedef float f32x4 __attribute__((ext_vector_type(4)));
typedef float f32x2 __attribute__((ext_vector_type(2)));
typedef unsigned u32x4 __attribute__((ext_vector_type(4)));
typedef unsigned u32x2 __attribute__((ext_vector_type(2)));
using pg8::cvtpk;

__device__ __forceinline__ float bf_lo(unsigned w) { return __uint_as_float(w << 16); }
__device__ __forceinline__ float bf_hi(unsigned w) { return __uint_as_float(w & 0xffff0000u); }
__device__ __forceinline__ s16x4 tr_read(const LAS unsigned char* p) { return __builtin_bit_cast(s16x4, __builtin_amdgcn_ds_read_tr16_b64_v4i16((LAS s16x4*)p)); }
__device__ __forceinline__ bf16x8 cat8(s16x4 lo, s16x4 hi) { return __builtin_shufflevector(lo, hi, 0, 1, 2, 3, 4, 5, 6, 7); }
#define MFMA16(a, b, c) __builtin_amdgcn_mfma_f32_16x16x32_bf16((a), (b), (c), 0, 0, 0)

constexpr int VP = 144;
constexpr int ATT_WAVE_LDS = 64 * VP + 1040;
__device__ __forceinline__ void att_load_k(bf16x8 (&k)[4][2], const bf16* kb, int fr, int fq) {
#pragma unroll
    for (int kt = 0; kt < 4; ++kt)
#pragma unroll
        for (int ks = 0; ks < 2; ++ks) k[kt][ks] = *(const bf16x8*)(kb + (size_t)(kt * 16 + fr) * PW + ks * 32 + fq * 8);
}
__device__ __forceinline__ void att_load_v(u32x4 (&v)[8], const bf16* vb, int lane) {
#pragma unroll
    for (int i = 0; i < 8; ++i) v[i] = *(const u32x4*)(vb + (size_t)(i * 8 + (lane >> 3)) * PW + (lane & 7) * 8);
}
__device__ __forceinline__ void att_store_v(LAS unsigned char* Vl, const u32x4 (&v)[8], int lane) {
#pragma unroll
    for (int i = 0; i < 8; ++i) *(LAS u32x4*)(Vl + (i * 8 + (lane >> 3)) * VP + (lane & 7) * 16) = v[i];
}
__device__ __forceinline__ void attn_item(const bf16* proj, bf16* mixed, const float* relb, int b, int c, int hg, LAS unsigned char* lds, int wid, int lane) {
    const int h = hg * 4 + (wid >> 1), qh = wid & 1, fr = lane & 15, fq = lane >> 4;
    LAS unsigned char* Vl = lds + wid * ATT_WAVE_LDS;
    LAS float* tb = (LAS float*)(Vl + 64 * VP);
    const size_t tokq = (size_t)b * SEQ + (size_t)c * 64 + qh * 32;
    bf16x8 qf[2][2];
#pragma unroll
    for (int qt = 0; qt < 2; ++qt)
#pragma unroll
        for (int ks = 0; ks < 2; ++ks) qf[qt][ks] = *(const bf16x8*)(proj + (tokq + qt * 16 + fr) * PW + h * 64 + ks * 32 + fq * 8);
    for (int i = lane; i < 257; i += 64) tb[i] = relb[h * 257 + i] * LOG2E;
    float mrun[2] = {-1e30f, -1e30f}, lrun[2] = {0.f, 0.f};
    f32x4 o[4][2];
#pragma unroll
    for (int dt = 0; dt < 4; ++dt)
#pragma unroll
        for (int qt = 0; qt < 2; ++qt) o[dt][qt] = (f32x4){0.f, 0.f, 0.f, 0.f};
    const int j0 = (c < 8) ? 8 - c : 0;
    const bf16* kbase = proj + ((size_t)b * SEQ) * PW + COL_K + h * 64;
    bf16x8 kf[4][2]; u32x4 vn[8];
    { const bf16* kb = kbase + (size_t)(c - 8 + j0) * 64 * PW; att_load_k(kf, kb, fr, fq); att_load_v(vn, kb + (COL_V - COL_K), lane); }
    att_store_v(Vl, vn, lane);
    asm volatile("" ::: "memory");
    const int iq0 = qh * 32 + fr;
    for (int j = j0; j <= 8; ++j) {
        bf16x8 kn[4][2];
        { const int jn = (j < 8) ? j + 1 : 8; const bf16* kb = kbase + (size_t)(c - 8 + jn) * 64 * PW; att_load_k(kn, kb, fr, fq); att_load_v(vn, kb + (COL_V - COL_K), lane); }
        f32x4 s[4][2];
#pragma unroll
        for (int kt = 0; kt < 4; ++kt)
#pragma unroll
            for (int qt = 0; qt < 2; ++qt) { f32x4 a = (f32x4){0.f, 0.f, 0.f, 0.f}; a = MFMA16(kf[kt][0], qf[qt][0], a); a = MFMA16(kf[kt][1], qf[qt][1], a); s[kt][qt] = a; }
        if (j <= 5) { const float bc = tb[256];
#pragma unroll
            for (int kt = 0; kt < 4; ++kt)
#pragma unroll
                for (int qt = 0; qt < 2; ++qt) s[kt][qt] = s[kt][qt] + bc;
        } else { const int cb = 512 - 64 * j;
#pragma unroll
            for (int kt = 0; kt < 4; ++kt)
#pragma unroll
                for (int qt = 0; qt < 2; ++qt)
#pragma unroll
                    for (int r = 0; r < 4; ++r) { int rel = (iq0 + qt * 16) - (kt * 16 + 4 * fq + r) + cb; rel = rel < -128 ? -128 : (rel > 128 ? 128 : rel); s[kt][qt][r] += tb[rel + 128]; }
        }
        bf16x8 pf[2][2];
#pragma unroll
        for (int qt = 0; qt < 2; ++qt) {
            float mx = s[0][qt][0];
#pragma unroll
            for (int kt = 0; kt < 4; ++kt)
#pragma unroll
                for (int r = 0; r < 4; ++r) mx = fmaxf(mx, s[kt][qt][r]);
            mx = fmaxf(mx, __shfl_xor(mx, 16)); mx = fmaxf(mx, __shfl_xor(mx, 32));
            const float mn = fmaxf(mrun[qt], mx), al = __builtin_amdgcn_exp2f(mrun[qt] - mn); mrun[qt] = mn;
            float ps = 0.f;
#pragma unroll
            for (int kt = 0; kt < 4; ++kt)
#pragma unroll
                for (int r = 0; r < 4; ++r) { const float p = __builtin_amdgcn_exp2f(s[kt][qt][r] - mn); s[kt][qt][r] = p; ps += p; }
            lrun[qt] = lrun[qt] * al + ps;
#pragma unroll
            for (int dt = 0; dt < 4; ++dt) o[dt][qt] = o[dt][qt] * al;
#pragma unroll
            for (int s2 = 0; s2 < 2; ++s2) { u32x4 w; w.x = cvtpk(s[2 * s2][qt][0], s[2 * s2][qt][1]); w.y = cvtpk(s[2 * s2][qt][2], s[2 * s2][qt][3]);
                w.z = cvtpk(s[2 * s2 + 1][qt][0], s[2 * s2 + 1][qt][1]); w.w = cvtpk(s[2 * s2 + 1][qt][2], s[2 * s2 + 1][qt][3]); pf[qt][s2] = __builtin_bit_cast(bf16x8, w); }
        }
        const LAS unsigned char* vrd = Vl + (4 * fq + (fr >> 2)) * VP + (lane & 3) * 8;
#pragma unroll
        for (int s2 = 0; s2 < 2; ++s2)
#pragma unroll
            for (int dt = 0; dt < 4; ++dt) {
                const s16x4 lo = tr_read(vrd + (32 * s2) * VP + dt * 32), hi = tr_read(vrd + (32 * s2 + 16) * VP + dt * 32);
                const bf16x8 vf = cat8(lo, hi);
#pragma unroll
                for (int qt = 0; qt < 2; ++qt) o[dt][qt] = MFMA16(vf, pf[qt][s2], o[dt][qt]);
            }
        asm volatile("" ::: "memory");
        att_store_v(Vl, vn, lane);
        asm volatile("" ::: "memory");
#pragma unroll
        for (int kt = 0; kt < 4; ++kt)
#pragma unroll
            for (int ks = 0; ks < 2; ++ks) kf[kt][ks] = kn[kt][ks];
    }
#pragma unroll
    for (int qt = 0; qt < 2; ++qt) {
        float l = lrun[qt]; l += __shfl_xor(l, 16); l += __shfl_xor(l, 32);
        const float inv = 1.0f / l; float q = 0.f;
#pragma unroll
        for (int dt = 0; dt < 4; ++dt) { o[dt][qt] = o[dt][qt] * inv; const f32x4 v = o[dt][qt]; q += (v[0] * v[0] + v[1] * v[1]) + (v[2] * v[2] + v[3] * v[3]); }
        q += __shfl_xor(q, 16); q += __shfl_xor(q, 32);
        const float rs = __builtin_amdgcn_rsqf(q * (1.0f / 64.0f) + EPS);
        bf16* op = mixed + (tokq + qt * 16 + fr) * DM + h * 64 + 4 * fq;
#pragma unroll
        for (int dt = 0; dt < 4; ++dt) { const f32x4 v = o[dt][qt] * rs; u32x2 w; w.x = cvtpk(v[0], v[1]); w.y = cvtpk(v[2], v[3]); *(u32x2*)(op + dt * 16) = w; }
    }
}

__device__ __forceinline__ void unpack8(float (&f)[8], u32x4 w) { f[0] = bf_lo(w.x); f[1] = bf_hi(w.x); f[2] = bf_lo(w.y); f[3] = bf_hi(w.y); f[4] = bf_lo(w.z); f[5] = bf_hi(w.z); f[6] = bf_lo(w.w); f[7] = bf_hi(w.w); }
__device__ __forceinline__ void conv_item(const bf16* proj, bf16* mixed, const float* cw, int item, int tid) {
    const int oc = tid & 31, c0 = oc * 8;
    float w0[8], w1[8], w2[8];
#pragma unroll
    for (int i = 0; i < 8; ++i) { w0[i] = cw[c0 + i]; w1[i] = cw[256 + c0 + i]; w2[i] = cw[512 + c0 + i]; }
#pragma unroll 1
    for (int pass = 0; pass < 4; ++pass) {
        const int t = item * 64 + pass * 16 + (tid >> 5), ts = t & (SEQ - 1);
        const bf16* rp = proj + (size_t)t * PW + c0;
        float bg[8], z[8], y[8], a[8], x[8];
        unpack8(bg, *(const u32x4*)(rp + COL_BG));
        unpack8(a, *(const u32x4*)(rp + COL_CG)); unpack8(x, *(const u32x4*)(rp + COL_XH));
#pragma unroll
        for (int i = 0; i < 8; ++i) y[i] = w2[i] * (a[i] * x[i]);
        if (ts >= 1) { unpack8(a, *(const u32x4*)(rp - PW + COL_CG)); unpack8(x, *(const u32x4*)(rp - PW + COL_XH));
#pragma unroll
            for (int i = 0; i < 8; ++i) y[i] += w1[i] * (a[i] * x[i]); }
        if (ts >= 2) { unpack8(a, *(const u32x4*)(rp - 2 * PW + COL_CG)); unpack8(x, *(const u32x4*)(rp - 2 * PW + COL_XH));
#pragma unroll
            for (int i = 0; i < 8; ++i) y[i] += w0[i] * (a[i] * x[i]); }
        float q = 0.f;
#pragma unroll
        for (int i = 0; i < 8; ++i) { z[i] = bg[i] * y[i]; q += z[i] * z[i]; }
        q += __shfl_xor(q, 1); q += __shfl_xor(q, 2); q += __shfl_xor(q, 4);
        const float rs = __builtin_amdgcn_rsqf(q * (1.0f / 64.0f) + EPS);
        u32x4 w; w.x = cvtpk(z[0] * rs, z[1] * rs); w.y = cvtpk(z[2] * rs, z[3] * rs); w.z = cvtpk(z[4] * rs, z[5] * rs); w.w = cvtpk(z[6] * rs, z[7] * rs);
        *(u32x4*)(mixed + (size_t)t * DM + 512 + c0) = w;
    }
}

constexpr int GP = 544;
__device__ __forceinline__ void gate_item(const bf16* proj, bf16* mixed, const float* lng, const float* lnb, const bf16* wsb, const float* sgb, int blk, LAS unsigned char* lds, int tid, int wid, int lane) {
    const size_t tok0 = (size_t)blk * 128;
    { const int tk = tid >> 2, part = tid & 3;
        const bf16* rp = proj + (tok0 + tk) * PW + COL_SV + part * 64;
        float x[64];
#pragma unroll
        for (int i = 0; i < 8; ++i) { float f[8]; unpack8(f, *(const u32x4*)(rp + i * 8));
#pragma unroll
            for (int k = 0; k < 8; ++k) x[i * 8 + k] = f[k]; }
        float sm = 0.f;
#pragma unroll
        for (int i = 0; i < 64; ++i) sm += x[i];
        sm += __shfl_xor(sm, 1); sm += __shfl_xor(sm, 2);
        const float mu = sm * (1.0f / 256.0f); float q = 0.f;
#pragma unroll
        for (int i = 0; i < 64; ++i) { x[i] -= mu; q += x[i] * x[i]; }
        q += __shfl_xor(q, 1); q += __shfl_xor(q, 2);
        const float rs = __builtin_amdgcn_rsqf(q * (1.0f / 256.0f) + EPS);
        LAS unsigned char* wp = lds + tk * GP + part * 128;
#pragma unroll
        for (int i = 0; i < 8; ++i) { const f32x4 g0 = *(const f32x4*)(lng + part * 64 + i * 8), g1 = *(const f32x4*)(lng + part * 64 + i * 8 + 4), b0 = *(const f32x4*)(lnb + part * 64 + i * 8), b1 = *(const f32x4*)(lnb + part * 64 + i * 8 + 4);
            u32x4 w; w.x = cvtpk(x[i * 8 + 0] * rs * g0[0] + b0[0], x[i * 8 + 1] * rs * g0[1] + b0[1]); w.y = cvtpk(x[i * 8 + 2] * rs * g0[2] + b0[2], x[i * 8 + 3] * rs * g0[3] + b0[3]);
            w.z = cvtpk(x[i * 8 + 4] * rs * g1[0] + b1[0], x[i * 8 + 5] * rs * g1[1] + b1[1]); w.w = cvtpk(x[i * 8 + 6] * rs * g1[2] + b1[2], x[i * 8 + 7] * rs * g1[3] + b1[3]);
            *(LAS u32x4*)(wp + i * 16) = w; }
    }
    __syncthreads();
    {
        const int g = wid >> 1, th = wid & 1, fr = lane & 15, fq = lane >> 4;
        f32x4 acc[4][4];
#pragma unroll
        for (int ct = 0; ct < 4; ++ct)
#pragma unroll
            for (int tt = 0; tt < 4; ++tt) acc[ct][tt] = (f32x4){0.f, 0.f, 0.f, 0.f};
        const int nks = th ? 4 : 2;
        const LAS unsigned char* vrd = lds + (8 * fq + (fr >> 2)) * GP + g * 128 + (lane & 3) * 8;
        const bf16* wrow = wsb + ((size_t)g * 128 + th * 64 + fr) * 128 + 8 * fq;
#pragma unroll 1
        for (int ks = 0; ks < nks; ++ks) {
            bf16x8 vf[4];
#pragma unroll
            for (int ct = 0; ct < 4; ++ct) { const s16x4 lo = tr_read(vrd + (32 * ks) * GP + ct * 32), hi = tr_read(vrd + (32 * ks + 4) * GP + ct * 32); vf[ct] = cat8(lo, hi); }
#pragma unroll
            for (int tt = 0; tt < 4; ++tt) { const bf16x8 wf = *(const bf16x8*)(wrow + (size_t)(tt * 16) * 128 + ks * 32);
#pragma unroll
                for (int ct = 0; ct < 4; ++ct) acc[ct][tt] = MFMA16(vf[ct], wf, acc[ct][tt]); }
        }
#pragma unroll
        for (int tt = 0; tt < 4; ++tt) { const int t = th * 64 + tt * 16 + fr; const float bias = sgb[g * 128 + t];
            const bf16* up = proj + (tok0 + t) * PW + COL_SU + g * 64 + 4 * fq; float q = 0.f; f32x4 v[4];
#pragma unroll
            for (int ct = 0; ct < 4; ++ct) { const u32x2 uw = *(const u32x2*)(up + ct * 16); const f32x4 uu = (f32x4){bf_lo(uw.x), bf_hi(uw.x), bf_lo(uw.y), bf_hi(uw.y)};
                v[ct] = uu * (acc[ct][tt] + bias); q += (v[ct][0] * v[ct][0] + v[ct][1] * v[ct][1]) + (v[ct][2] * v[ct][2] + v[ct][3] * v[ct][3]); }
            q += __shfl_xor(q, 16); q += __shfl_xor(q, 32);
            const float rs = __builtin_amdgcn_rsqf(q * (1.0f / 64.0f) + EPS);
            bf16* op = mixed + (tok0 + t) * DM + 768 + g * 64 + 4 * fq;
#pragma unroll
            for (int ct = 0; ct < 4; ++ct) { const f32x4 r = v[ct] * rs; u32x2 w; w.x = cvtpk(r[0], r[1]); w.y = cvtpk(r[2], r[3]); *(u32x2*)(op + ct * 16) = w; }
        }
    }
    __syncthreads();
}

constexpr size_t MiB = 1u << 20;
constexpr size_t SZ_WIN = (size_t)PW * DM * 2, SZ_WOUT = (size_t)DM * DM * 2, SZ_WUP = (size_t)DFF * DM * 2, SZ_WDN = (size_t)DM * DFF * 2, SZ_WSG = (size_t)4 * 128 * 128 * 2;
constexpr size_t WS_WIN = 0;
constexpr size_t WS_WOUT = WS_WIN + DEPTH * SZ_WIN;
constexpr size_t WS_WUP = WS_WOUT + DEPTH * SZ_WOUT;
constexpr size_t WS_WDN = WS_WUP + DEPTH * SZ_WUP;
constexpr size_t WS_WSG = WS_WDN + DEPTH * SZ_WDN;
constexpr size_t WS_SS = WS_WSG + DEPTH * SZ_WSG;
constexpr size_t WS_XB = WS_SS + (size_t)M_TOK * 16 * 4;
constexpr size_t WS_PROJ = WS_XB + (size_t)M_TOK * DM * 2;
constexpr size_t WS_MIX = WS_PROJ + (size_t)M_TOK * PW * 2;
constexpr size_t WS_HDN = WS_PROJ;
constexpr size_t WS_END = WS_HDN + (size_t)M_TOK * DFF * 2;
static_assert(WS_MIX + (size_t)M_TOK * DM * 2 <= WS_END, "hdn covers proj + mixed");
static_assert(WS_WOUT % 256 == 0 && WS_WUP % 256 == 0 && WS_WDN % 256 == 0 && WS_WSG % 256 == 0 && WS_SS % 256 == 0 && WS_XB % 256 == 0 && WS_PROJ % 256 == 0 && WS_MIX % 256 == 0, "alignment");

constexpr int NWAVES = 8;
constexpr int LDS_BYTES = 132096;
static_assert(8 * ATT_WAVE_LDS <= 131072 && 128 * GP <= 131072, "LDS map");

__device__ __forceinline__ unsigned f2bf(float f) { unsigned u = __builtin_bit_cast(unsigned, f); return (u + 0x7fffu + ((u >> 16) & 1u)) >> 16; }
__device__ __forceinline__ unsigned pk2(float lo, float hi) { return f2bf(lo) | (f2bf(hi) << 16); }
__device__ __forceinline__ float wave_sum(float v) {
#pragma unroll
    for (int o = 1; o < 64; o <<= 1) v += __shfl_xor(v, o);
    return v;
}
__device__ __forceinline__ void p0_transpose_item(const float* W, const float* gain, int K, int N, bf16* WT, LAS float* scr, int item, int lane) {
    const int nblk = N / 32, kb = item / nblk, nb = item % nblk, k0 = 64 * kb, n0 = 32 * nb;
#pragma unroll 8
    for (int i = 0; i < 32; ++i) { const int kk = 2 * i + (lane >> 5); const float gsc = gain ? gain[k0 + kk] : 1.0f; scr[kk * 33 + (lane & 31)] = W[(size_t)(k0 + kk) * N + n0 + (lane & 31)] * gsc; }
    asm volatile("s_waitcnt lgkmcnt(0)" ::: "memory");
    const int c = lane & 7;
#pragma unroll
    for (int j = 0; j < 4; ++j) { const int n = (lane >> 3) + 8 * j; const LAS float* s = scr + (8 * c) * 33 + n;
        u32x4 o; o.x = pk2(s[0 * 33], s[1 * 33]); o.y = pk2(s[2 * 33], s[3 * 33]); o.z = pk2(s[4 * 33], s[5 * 33]); o.w = pk2(s[6 * 33], s[7 * 33]);
        *(u32x4*)(WT + (size_t)(n0 + n) * K + k0 + 8 * c) = o; }
    asm volatile("s_waitcnt lgkmcnt(0)" ::: "memory");
}

struct Args { const float* in[15]; float* out; unsigned char* ws; };

__global__ void __launch_bounds__(NWAVES * 64, 2) trunk_fwd(Args args) {
    extern __shared__ __attribute__((aligned(16))) unsigned char lds_raw[];
    cg::grid_group grid = cg::this_grid();
    LAS unsigned char* lds = (LAS unsigned char*)lds_raw;
    const int G = gridDim.x, bx = blockIdx.x;
    const int vcu = (G % 8 == 0) ? (bx % 8) * (G / 8) + bx / 8 : bx;
    unsigned char* ws = args.ws;
    const float* x_in = args.in[0];
    float* X = args.out;
    bf16* XB = (bf16*)(ws + WS_XB); float* SS = (float*)(ws + WS_SS);
    bf16* PROJ = (bf16*)(ws + WS_PROJ); bf16* MIXB = (bf16*)(ws + WS_MIX); bf16* HDN = (bf16*)(ws + WS_HDN);

    {
        int tid = threadIdx.x; asm volatile("" : "+v"(tid)); const int lane = tid & 63, wid = __builtin_amdgcn_readfirstlane(tid >> 6);
        LAS float* scr = (LAS float*)(lds + wid * 16384);
        const int gw = vcu * NWAVES + wid, NGW = G * NWAVES;
        constexpr int I_IN = (DM / 64) * (PW / 32), I_OUT = (DM / 64) * (DM / 32), I_UP = (DM / 64) * (DFF / 32), I_DN = (DFF / 64) * (DM / 32), I_L = I_IN + I_OUT + I_UP + I_DN;
        for (int it = gw; it < DEPTH * I_L; it += NGW) {
            const int l = it / I_L; int r = it % I_L;
            if (r < I_IN) { p0_transpose_item(args.in[2] + (size_t)l * DM * PW, args.in[1] + l * DM, DM, PW, (bf16*)(ws + WS_WIN + l * SZ_WIN), scr, r, lane); continue; } r -= I_IN;
            if (r < I_OUT) { p0_transpose_item(args.in[10] + (size_t)l * DM * DM, args.in[9] + l * DM, DM, DM, (bf16*)(ws + WS_WOUT + l * SZ_WOUT), scr, r, lane); continue; } r -= I_OUT;
            if (r < I_UP) { p0_transpose_item(args.in[12] + (size_t)l * DM * DFF, args.in[11] + l * DM, DM, DFF, (bf16*)(ws + WS_WUP + l * SZ_WUP), scr, r, lane); continue; } r -= I_UP;
            p0_transpose_item(args.in[13] + (size_t)l * DFF * DM, nullptr, DFF, DM, (bf16*)(ws + WS_WDN + l * SZ_WDN), scr, r, lane);
        }
        { const float* sw = args.in[7]; bf16* wsg = (bf16*)(ws + WS_WSG);
            for (int i = bx * 512 + tid; i < DEPTH * 4 * 128 * 128 / 2; i += G * 512) { const int e = 2 * i, t = (e >> 7) & 127, s = e & 127; const f32x2 v = *(const f32x2*)(sw + e);
                ((unsigned*)wsg)[i] = pk2(s <= t ? v.x : 0.f, (s + 1) <= t ? v.y : 0.f); } }
        for (int m = gw; m < M_TOK; m += NGW) {
            const f32x4* xr = (const f32x4*)(x_in + (size_t)m * DM) + lane; unsigned long long* o8 = (unsigned long long*)(XB + (size_t)m * DM) + lane; float q = 0.f;
#pragma unroll
            for (int j = 0; j < 4; ++j) { const f32x4 v = xr[64 * j]; q += (v.x * v.x + v.y * v.y) + (v.z * v.z + v.w * v.w); o8[64 * j] = (unsigned long long)pk2(v.x, v.y) | ((unsigned long long)pk2(v.z, v.w) << 32); }
            q = wave_sum(q);
            if (lane < 16) SS[(size_t)m * 16 + lane] = (lane == 0) ? q : 0.f;
        }
    }
    grid.sync();

#pragma unroll 1
    for (int l = 0; l < DEPTH; ++l) {
        {
            pg8::Gemm g{XB, (const bf16*)(ws + WS_WIN + l * SZ_WIN), M_TOK, PW, DM}; pg8::StaticOrder S; S.init(M_TOK, PW, G, bx);
            pg8::EpiAct<0, PW> E{PROJ, SS, QSCALE};
            pg8::gemm_phase<pg8::EpiAct<0, PW>, pg8::StaticOrder, true, true>(lds, g, S, E);
        }
        grid.sync();
        {
            int tid = threadIdx.x; asm volatile("" : "+v"(tid));
            const int lane = tid & 63, wid = __builtin_amdgcn_readfirstlane(tid >> 6);
            const float* relb = args.in[3] + (size_t)l * 8 * 257;
            for (int u = vcu; u < BATCH * 2 * NCHUNK; u += G) { const int c = u % NCHUNK, bh = u / NCHUNK; attn_item(PROJ, MIXB, relb, bh >> 1, c, bh & 1, lds, wid, lane); }
            for (int u = bx; u < M_TOK / 64; u += G) conv_item(PROJ, MIXB, args.in[4] + (size_t)l * 3 * 256, u, tid);
            __syncthreads();
            for (int u = bx; u < M_TOK / 128; u += G)
                gate_item(PROJ, MIXB, args.in[5] + l * 256, args.in[6] + l * 256, (const bf16*)(ws + WS_WSG + l * SZ_WSG), args.in[8] + l * 512, u, lds, tid, wid, lane);
        }
        grid.sync();
        {
            pg8::Gemm g{MIXB, (const bf16*)(ws + WS_WOUT + l * SZ_WOUT), M_TOK, DM, DM}; pg8::StaticOrder S; S.init(M_TOK, DM, G, bx);
            pg8::EpiRes E{l == 0 ? x_in : (const float*)X, X, XB, SS};
            pg8::gemm_phase<pg8::EpiRes, pg8::StaticOrder, true, true>(lds, g, S, E);
        }
        grid.sync();
        {
            pg8::Gemm g{XB, (const bf16*)(ws + WS_WUP + l * SZ_WUP), M_TOK, DFF, DM}; pg8::StaticOrder S; S.init(M_TOK, DFF, G, bx);
            pg8::EpiAct<1, DFF> E{HDN, SS, 1.0f};
            pg8::gemm_phase<pg8::EpiAct<1, DFF>, pg8::StaticOrder, true, true>(lds, g, S, E);
        }
        grid.sync();
        {
            pg8::Gemm g{HDN, (const bf16*)(ws + WS_WDN + l * SZ_WDN), M_TOK, DM, DFF}; pg8::StaticOrder S; S.init(M_TOK, DM, G, bx);
            pg8::EpiRes E{X, X, XB, SS};
            pg8::gemm_phase<pg8::EpiRes, pg8::StaticOrder, true, true>(lds, g, S, E);
        }
        grid.sync();
    }
    {
        int tidf = threadIdx.x; asm volatile("" : "+v"(tidf)); const int lane = tidf & 63, wid = __builtin_amdgcn_readfirstlane(tidf >> 6);
        const int gw = vcu * NWAVES + wid, NGW = G * NWAVES; const f32x4* gp = (const f32x4*)args.in[14] + lane;
        for (int m = gw; m < M_TOK; m += NGW) {
            f32x4* xr = (f32x4*)(X + (size_t)m * DM) + lane; f32x4 v[4]; float q = 0.f;
#pragma unroll
            for (int j = 0; j < 4; ++j) { v[j] = xr[64 * j]; q += (v[j].x * v[j].x + v[j].y * v[j].y) + (v[j].z * v[j].z + v[j].w * v[j].w); }
            const float rs = 1.0f / sqrtf(wave_sum(q) * (1.0f / DM) + EPS);
#pragma unroll
            for (int j = 0; j < 4; ++j) xr[64 * j] = v[j] * rs * gp[64 * j];
        }
    }
}

extern "C" void kernel_launch(void* const* d_in, const int* in_sizes, int n_in, void* d_out, int out_size, void* d_ws, size_t ws_size, hipStream_t stream) {
    static int grid = 0;
    if (grid == 0) {
        if (n_in != 15 || in_sizes[0] != M_TOK * DM || out_size != M_TOK * DM || ws_size < WS_END) { fprintf(stderr, "kernel_launch: unexpected shapes (n_in %d, in0 %d, out %d, ws %zu < %zu); nothing launched\n", n_in, n_in > 0 ? in_sizes[0] : -1, out_size, ws_size, (size_t)WS_END); grid = -1; return; }
        int dev = 0, cus = 0, per_cu = 0;
        if (hipGetDevice(&dev) != hipSuccess || hipDeviceGetAttribute(&cus, hipDeviceAttributeMultiprocessorCount, dev) != hipSuccess) { grid = -1; return; }
        if (hipFuncSetAttribute((const void*)trunk_fwd, hipFuncAttributeMaxDynamicSharedMemorySize, LDS_BYTES) != hipSuccess) { fprintf(stderr, "kernel_launch: hipFuncSetAttribute failed\n"); grid = -1; return; }
        if (hipOccupancyMaxActiveBlocksPerMultiprocessor(&per_cu, (const void*)trunk_fwd, NWAVES * 64, LDS_BYTES) != hipSuccess || per_cu < 1) { fprintf(stderr, "kernel_launch: occupancy query says %d blocks per CU\n", per_cu); per_cu = 1; }
        (void)hipGetLastError();
        grid = cus * per_cu;
    }
    if (grid < 0) return;
    Args a{};
    for (int i = 0; i < 15; ++i) a.in[i] = (const float*)d_in[i];
    a.out = (float*)d_out; a.ws = (unsigned char*)d_ws;
    void* kargs[] = {&a};
    hipError_t e = hipLaunchCooperativeKernel((const void*)trunk_fwd, dim3(grid), dim3(NWAVES * 64), kargs, LDS_BYTES, stream);
    if (e != hipSuccess) fprintf(stderr, "kernel_launch: cooperative launch failed: %s (grid %d)\n", hipGetErrorString(e), grid);
}
```

```cpp
#include <hip/hip_runtime.h>
#include <hip/hip_cooperative_groups.h>
#include <cstdio>
#include <cstdint>
namespace cg = cooperative_groups;
namespace pg8 {
#define PG8_LAS __attribute__((address_space(3)))
typedef unsigned short bf16_t;
typedef short bf16x8 __attribute__((ext_vector_type(8)));
typedef float f32x4 __attribute__((ext_vector_type(4)));
typedef unsigned u32x4 __attribute__((ext_vector_type(4)));
constexpr int BM = 256, BK = 64, HALF = 128, HTB = HALF * BK * 2  , STAGE_BYTES = 8 * HTB, NXCD = 8, WGM = 8;

__host__ __device__ __forceinline__ int lds_byte(int r, int c) { const int st = (r >> 4) * 2 + (c >> 5), rr = r & 15, cc = c & 31, ob = rr * 64 + cc * 2; return st * 1024 + (ob ^ (((ob >> 9) & 1) << 5)); }
__host__ __device__ __forceinline__ void stage_rc(int b, int& R, int& C) { const int st = b / 1024, sb = b % 1024, swz = sb ^ (((sb >> 9) & 1) << 5); R = (st >> 1) * 16 + swz / 64; C = (st & 1) * 32 + (swz % 64) / 2; }
__host__ __device__ __forceinline__ int perm32(int rho) { const int n = rho >> 4, i = rho & 15; return 8 * (i >> 2) + 4 * n + (i & 3); }

struct Unit { int pm, pn; };
struct Gemm { const bf16_t* A; const bf16_t* Bt; int M, N, K; };

struct StaticOrder {
    int nM, nN, nwg, G, c;
    __host__ __device__ void init(int M, int N, int G_, int c_) { nM = M / BM; nN = N / BM; nwg = nM * nN; G = G_; c = c_; }
    __host__ __device__ bool next(int i, Unit& u) const {
        const long L = (long)i * G + c; if (L >= nwg) return false;
        int wgid = (int)L; { const int q = nwg / NXCD, r = nwg % NXCD, xcd = wgid % NXCD, off = wgid / NXCD; wgid = (xcd < r ? xcd * (q + 1) : r * (q + 1) + (xcd - r) * q) + off; }
        const int nig = WGM * nN, gid = wgid / nig, fm = gid * WGM, gsz = (nM - fm) < WGM ? (nM - fm) : WGM;
        u.pm = fm + ((wgid % nig) % gsz); u.pn = (wgid % nig) / gsz; return true;
    }
    __device__ __forceinline__ void a_ready(const Unit&) const {}
    __device__ __forceinline__ void done(const Unit&) const {}
};

__device__ __forceinline__ unsigned cvt_pk_bf16(float lo, float hi) { unsigned r; asm volatile("v_cvt_pk_bf16_f32 %0, %1, %2" : "=v"(r) : "v"(lo), "v"(hi)); return r; }
typedef float f32x2 __attribute__((ext_vector_type(2)));
__device__ __forceinline__ f32x2 gelu_pk(f32x2 v) {
    const f32x2 av = __builtin_elementwise_abs(v), d = av * 0.2316418882f + 1.0f;
    f32x2 t; t.x = __builtin_amdgcn_rcpf(d.x); t.y = __builtin_amdgcn_rcpf(d.y);
    f32x2 q = t * 0.5307027145f + (-0.7265760135f); q = q * t + 0.7107068705f; q = q * t + (-0.142248368f); q = q * t + 0.127414796f; q = q * t;
    const f32x2 s = (v * v) * (-0.72134752044f);
    f32x2 e; e.x = __builtin_amdgcn_exp2f(s.x); e.y = __builtin_amdgcn_exp2f(s.y);
    const f32x2 m = v * (q * e), r = v - m;
    f32x2 o; o.x = v.x < 0.f ? m.x : r.x; o.y = v.y < 0.f ? m.y : r.y; return o;
}


typedef unsigned u32x2 __attribute__((ext_vector_type(2)));
typedef __bf16 bf16x2_t __attribute__((ext_vector_type(2)));
__device__ __forceinline__ unsigned cvtpk(float lo, float hi) { f32x2 v = {lo, hi}; bf16x2_t b = __builtin_convertvector(v, bf16x2_t); return __builtin_bit_cast(unsigned, b); }
constexpr float RMS_EPS = 1e-6f;
__device__ __forceinline__ float row_rstd(const char* rec) {
    const f32x4* p = (const f32x4*)rec;
    const f32x4 a = p[0], b = p[1], c = p[2], d = p[3];
    const f32x4 s = (a + b) + (c + d);
    const float t = (s[0] + s[1]) + (s[2] + s[3]);
    return __builtin_amdgcn_rsqf(t * (1.0f / 1024.0f) + RMS_EPS);
}
template <int MODE, int LDC> struct EpiAct {
    static constexpr bool PERM = true, AFTER_DRAIN = false;
    bf16_t* O; const float* ss; float qscale;
    __device__ __forceinline__ void operator()(const f32x4 (&acc)[2][2][4][2], const Unit& u, int wr, int wc, int fr, int fq) const {
        const int rl = wr * 64 + fr;
        unsigned ooff = (unsigned)(rl * LDC + wc * 32 + 8 * fq) * 2u, soff = (unsigned)rl * 64u;
        asm volatile("" : "+v"(ooff), "+v"(soff));
        char* obase = (char*)O + ((size_t)u.pm * BM * LDC + (size_t)u.pn * BM) * 2;
        const char* sbase = (const char*)ss + (size_t)u.pm * BM * 64;
        const float sc = (MODE == 0 && u.pn < 2) ? qscale : 1.0f; const bool act = (MODE == 0 && u.pn >= 9);
#pragma unroll
        for (int ai = 0; ai < 2; ++ai)
#pragma unroll
            for (int m = 0; m < 4; ++m) { const int ro = ai * HALF + m * 16; const float rs = row_rstd(sbase + soff + ro * 64) * sc; char* rowp = obase + ooff + (size_t)ro * LDC * 2;
#pragma unroll
                for (int bj = 0; bj < 2; ++bj) { f32x4 v0 = acc[ai][bj][m][0] * rs, v1 = acc[ai][bj][m][1] * rs;
                    if (MODE == 0) { if (act) { f32x2 a = gelu_pk((f32x2){v0[0], v0[1]}), b = gelu_pk((f32x2){v0[2], v0[3]}), c = gelu_pk((f32x2){v1[0], v1[1]}), d = gelu_pk((f32x2){v1[2], v1[3]});
                        v0 = (f32x4){a.x, a.y, b.x, b.y}; v1 = (f32x4){c.x, c.y, d.x, d.y}; } }
                    else { v0 = __builtin_elementwise_max(v0, (f32x4){0.f, 0.f, 0.f, 0.f}); v1 = __builtin_elementwise_max(v1, (f32x4){0.f, 0.f, 0.f, 0.f}); v0 = v0 * v0; v1 = v1 * v1; }
                    u32x4 w; w.x = cvtpk(v0[0], v0[1]); w.y = cvtpk(v0[2], v0[3]); w.z = cvtpk(v1[0], v1[1]); w.w = cvtpk(v1[2], v1[3]);
                    *(u32x4*)(rowp + bj * HALF * 2) = w; } }
    }
};
struct EpiRes {
    static constexpr bool PERM = false, AFTER_DRAIN = false;
    const float* base; float* out; bf16_t* xb; float* ss;
    __device__ __forceinline__ void operator()(const f32x4 (&acc)[2][2][4][2], const Unit& u, int wr, int wc, int fr, int fq) const {
        const int rl = wr * 64 + fr;
        unsigned eoff = (unsigned)(rl * 1024 + wc * 32 + 4 * fq), soff = (unsigned)(rl * 16 + wc) * 4u;
        asm volatile("" : "+v"(eoff), "+v"(soff));
        const size_t tile = (size_t)u.pm * BM * 1024 + (size_t)u.pn * BM;
        const char* bbase = (const char*)(base + tile); char* obase = (char*)(out + tile); char* xbase = (char*)(xb + tile);
        char* sbase = (char*)ss + (size_t)u.pm * BM * 64 + u.pn * 16;
#pragma unroll
        for (int ai = 0; ai < 2; ++ai)
#pragma unroll
            for (int m = 0; m < 4; ++m) { const int ro = ai * HALF + m * 16; float q = 0.f;
#pragma unroll
                for (int bj = 0; bj < 2; ++bj)
#pragma unroll
                    for (int n = 0; n < 2; ++n) { const unsigned e = eoff + ro * 1024 + bj * HALF + n * 16;
                        const f32x4 b = *(const f32x4*)(bbase + (size_t)e * 4); const f32x4 o = b + acc[ai][bj][m][n];
                        *(f32x4*)(obase + (size_t)e * 4) = o; u32x2 w; w.x = cvtpk(o[0], o[1]); w.y = cvtpk(o[2], o[3]); *(u32x2*)(xbase + (size_t)e * 2) = w;
                        q += (o[0] * o[0] + o[1] * o[1]) + (o[2] * o[2] + o[3] * o[3]); }
                q += __shfl_xor(q, 16); q += __shfl_xor(q, 32);
                if (fq == 0) *(float*)(sbase + soff + ro * 64) = q; }
    }
};
template <class Epi, class Sched, bool ALIGN_EPI = false, bool SP2 = false>
__device__ __forceinline__ void gemm_phase(PG8_LAS unsigned char* lds, const Gemm g, const Sched& S, const Epi& E) {
    int tid_ = threadIdx.x; asm volatile("" : "+v"(tid_));
    const int tid = tid_, wid = __builtin_amdgcn_readfirstlane(tid >> 6), lane = tid & 63, wr = wid >> 2, wc = wid & 3, fr = lane & 15, fq = lane >> 4;
    const int K = g.K, nt = K / BK;
    unsigned voffA[2], voffB[2];
#pragma unroll
    for (int i = 0; i < 2; ++i) { int R, C; stage_rc(tid * 16 + i * 8192, R, C); const int Rb = Epi::PERM ? ((R & ~31) + perm32(R & 31)) : R;
        voffA[i] = (unsigned)(R * K + C) * 2u; voffB[i] = (unsigned)(Rb * K + C) * 2u; }
    const size_t kstep = (size_t)(BK * 2);
    const size_t hstep = (size_t)HALF * K * 2;
    const size_t tstep = 2 * hstep;
    const unsigned ldsw = (unsigned)wid * 1024u;
    const int aoff = lds_byte(wr * 64 + fr, fq * 8), boff = lds_byte(wc * 32 + fr, fq * 8);
#define PG8_SA(b, h) (((b) * 2 + (h)) * HTB)
#define PG8_SB(b, h) ((4 + (b) * 2 + (h)) * HTB)
#define PG8_STAGE(bufoff, gbase, voff) do { _Pragma("unroll") for (int _i = 0; _i < 2; ++_i) \
        __builtin_amdgcn_global_load_lds((const unsigned*)((const char*)(gbase) + (voff)[_i]), (PG8_LAS unsigned*)(lds + (bufoff) + ldsw + _i * 8192), 16, 0, 0); } while (0)
#define PG8_LDA(dst, b, h) do { _Pragma("unroll") for (int m = 0; m < 4; ++m) _Pragma("unroll") for (int k = 0; k < 2; ++k) dst[m][k] = *(const PG8_LAS bf16x8*)(lds + PG8_SA(b, h) + aoff + m * 2048 + k * 1024); } while (0)
#define PG8_LDB(dst, b, h) do { _Pragma("unroll") for (int n = 0; n < 2; ++n) _Pragma("unroll") for (int k = 0; k < 2; ++k) dst[n][k] = *(const PG8_LAS bf16x8*)(lds + PG8_SB(b, h) + boff + n * 2048 + k * 1024); } while (0)
#define PG8_MMA(ai, bj, At, Bt) do { __builtin_amdgcn_s_setprio(1); _Pragma("unroll") for (int m = 0; m < 4; ++m) _Pragma("unroll") for (int n = 0; n < 2; ++n) _Pragma("unroll") for (int k = 0; k < 2; ++k) \
        acc[ai][bj][m][n] = __builtin_amdgcn_mfma_f32_16x16x32_bf16(Bt[n][k], At[m][k], acc[ai][bj][m][n], 0, 0, 0); __builtin_amdgcn_s_setprio(0); } while (0)
#define PG8_WAIT_V(n) asm volatile("s_waitcnt vmcnt(" #n ")" ::: "memory")
#define PG8_WAIT_L(n) asm volatile("s_waitcnt lgkmcnt(" #n ")" ::: "memory")
#define PG8_BAR __builtin_amdgcn_s_barrier()
#define PG8_SCHED __builtin_amdgcn_sched_barrier(0)
    Unit cur, nxt; int ui = 0;
    if (!S.next(0, cur)) return;
    f32x4 acc[2][2][4][2];
#pragma unroll
    for (int a = 0; a < 2; ++a)
#pragma unroll
        for (int b = 0; b < 2; ++b)
#pragma unroll
            for (int m = 0; m < 4; ++m)
#pragma unroll
                for (int n = 0; n < 2; ++n) acc[a][b][m][n] = (f32x4){0.f, 0.f, 0.f, 0.f};
    bf16x8 At[4][2], B0[2][2], B1[2][2];
    const char* cA = (const char*)g.A + (size_t)cur.pm * tstep; const char* cB = (const char*)g.Bt + (size_t)cur.pn * tstep;
    S.a_ready(cur);
    if constexpr (SP2) {
        PG8_STAGE(PG8_SB(0, 0), cB, voffB); PG8_STAGE(PG8_SB(0, 1), cB + hstep, voffB); PG8_STAGE(PG8_SA(0, 0), cA, voffA); PG8_STAGE(PG8_SA(0, 1), cA + hstep, voffA);
        if (wr == 1) PG8_BAR;
        PG8_WAIT_V(2); PG8_BAR;
        PG8_STAGE(PG8_SB(1, 0), cB + kstep, voffB); PG8_STAGE(PG8_SA(1, 0), cA + kstep, voffA); PG8_STAGE(PG8_SB(1, 1), cB + hstep + kstep, voffB);
        PG8_WAIT_V(6); PG8_BAR;
    } else {
        PG8_STAGE(PG8_SB(0, 0), cB, voffB); PG8_STAGE(PG8_SA(0, 0), cA, voffA); PG8_STAGE(PG8_SB(0, 1), cB + hstep, voffB); PG8_STAGE(PG8_SA(0, 1), cA + hstep, voffA);
        if (wr == 1) PG8_BAR;
        PG8_WAIT_V(4); PG8_BAR;
        PG8_STAGE(PG8_SB(1, 0), cB + kstep, voffB); PG8_STAGE(PG8_SA(1, 0), cA + kstep, voffA); PG8_STAGE(PG8_SB(1, 1), cB + hstep + kstep, voffB);
        PG8_WAIT_V(6); PG8_BAR;
    }
    for (;;) {
        const bool has_next = S.next(ui + 1, nxt);
        const char* nA = has_next ? (const char*)g.A + (size_t)nxt.pm * tstep : cA; const char* nB = has_next ? (const char*)g.Bt + (size_t)nxt.pn * tstep : cB;
        for (int t = 0; t < nt; t += 2) {
            const bool last = (t == nt - 2);
            const char* a1 = cA + (size_t)(t + 1) * kstep;
            const char* a2 = last ? nA : cA + (size_t)(t + 2) * kstep; const char* b2 = last ? nB : cB + (size_t)(t + 2) * kstep;
            const char* a3 = a2 + kstep; const char* b3 = b2 + kstep;
            if (last && has_next) S.a_ready(nxt);
            if constexpr (SP2) {
            PG8_LDB(B0, 0, 0); PG8_LDB(B1, 0, 1); PG8_SCHED; PG8_LDA(At, 0, 0); PG8_STAGE(PG8_SA(1, 1), a1 + hstep, voffA);
            PG8_WAIT_V(8); PG8_WAIT_L(0); PG8_BAR; PG8_MMA(0, 0, At, B0); PG8_MMA(0, 1, At, B1); PG8_BAR; PG8_SCHED;
            PG8_LDA(At, 0, 1); PG8_STAGE(PG8_SB(0, 0), b2, voffB); PG8_STAGE(PG8_SB(0, 1), b2 + hstep, voffB); PG8_STAGE(PG8_SA(0, 0), a2, voffA);
            PG8_WAIT_V(8); PG8_WAIT_L(0); PG8_BAR; PG8_MMA(1, 0, At, B0); PG8_MMA(1, 1, At, B1); PG8_BAR; PG8_SCHED;
            PG8_LDB(B0, 1, 0); PG8_LDB(B1, 1, 1); PG8_SCHED; PG8_LDA(At, 1, 0); PG8_STAGE(PG8_SA(0, 1), a2 + hstep, voffA);
            PG8_WAIT_V(8); PG8_WAIT_L(0); PG8_BAR; PG8_MMA(0, 0, At, B0); PG8_MMA(0, 1, At, B1); PG8_BAR; PG8_SCHED;
            PG8_LDA(At, 1, 1); PG8_STAGE(PG8_SB(1, 0), b3, voffB); PG8_STAGE(PG8_SB(1, 1), b3 + hstep, voffB); PG8_STAGE(PG8_SA(1, 0), a3, voffA);
            PG8_WAIT_V(8); PG8_WAIT_L(0); PG8_BAR; PG8_MMA(1, 0, At, B0); PG8_MMA(1, 1, At, B1); PG8_BAR; PG8_SCHED;
            } else {
            PG8_LDB(B0, 0, 0); PG8_SCHED; PG8_LDA(At, 0, 0); PG8_STAGE(PG8_SA(1, 1), a1 + hstep, voffA);
            PG8_WAIT_L(8); PG8_BAR; PG8_WAIT_L(0); PG8_MMA(0, 0, At, B0); PG8_BAR; PG8_SCHED;
            PG8_LDB(B1, 0, 1); PG8_STAGE(PG8_SB(0, 0), b2, voffB);
            PG8_BAR; PG8_WAIT_L(0); PG8_MMA(0, 1, At, B1); PG8_BAR;
            PG8_LDA(At, 0, 1); PG8_STAGE(PG8_SA(0, 0), a2, voffA);
            PG8_BAR; PG8_WAIT_L(0); PG8_MMA(1, 0, At, B0); PG8_BAR; PG8_SCHED;
            PG8_STAGE(PG8_SB(0, 1), b2 + hstep, voffB);
            PG8_WAIT_V(6); PG8_BAR; PG8_MMA(1, 1, At, B1); PG8_BAR;
            PG8_LDB(B0, 1, 0); PG8_SCHED; PG8_LDA(At, 1, 0); PG8_STAGE(PG8_SA(0, 1), a2 + hstep, voffA);
            PG8_WAIT_L(8); PG8_BAR; PG8_WAIT_L(0); PG8_MMA(0, 0, At, B0); PG8_BAR; PG8_SCHED;
            PG8_LDB(B1, 1, 1); PG8_STAGE(PG8_SB(1, 0), b3, voffB);
            PG8_BAR; PG8_WAIT_L(0); PG8_MMA(0, 1, At, B1); PG8_BAR;
            PG8_LDA(At, 1, 1); PG8_STAGE(PG8_SA(1, 0), a3, voffA);
            PG8_BAR; PG8_WAIT_L(0); PG8_MMA(1, 0, At, B0); PG8_BAR; PG8_SCHED;
            PG8_STAGE(PG8_SB(1, 1), b3 + hstep, voffB);
            PG8_WAIT_V(6); PG8_BAR; PG8_MMA(1, 1, At, B1); PG8_BAR;
            }
        }
        if constexpr (ALIGN_EPI) { if (wr == 0) PG8_BAR; }
        if constexpr (!Epi::AFTER_DRAIN) { E(acc, cur, wr, wc, fr, fq); S.done(cur); }
        if (!has_next) break;
#pragma unroll
        for (int a = 0; a < 2; ++a)
#pragma unroll
            for (int b = 0; b < 2; ++b)
#pragma unroll
                for (int m = 0; m < 4; ++m)
#pragma unroll
                    for (int n = 0; n < 2; ++n) acc[a][b][m][n] = (f32x4){0.f, 0.f, 0.f, 0.f};
        cur = nxt; cA = nA; cB = nB; ++ui;
        if constexpr (ALIGN_EPI) { if (wr == 1) PG8_BAR; }
    }
    PG8_WAIT_V(0);
    if constexpr (!ALIGN_EPI) { if (wr == 0) PG8_BAR; }
    PG8_BAR;
    if constexpr (Epi::AFTER_DRAIN) { E.fused(acc, cur, wr, wc, fr, fq, lds, wid, lane); S.done(cur); }
#undef PG8_SA
#undef PG8_SB
#undef PG8_STAGE
#undef PG8_LDA
#undef PG8_LDB
#undef PG8_MMA
#undef PG8_WAIT_V
#undef PG8_WAIT_L
#undef PG8_BAR
#undef PG8_SCHED
}
}

constexpr int BATCH = 2, SEQ = 16384, DM = 1024, DEPTH = 4, M_TOK = BATCH * SEQ;
constexpr int PW = 2816;
constexpr int COL_K = 512, COL_V = 1024, COL_BG = 1536, COL_CG = 1792, COL_XH = 2048, COL_SU = 2304, COL_SV = 2560;
constexpr int DFF = 4096, NCHUNK = SEQ / 64;
constexpr float LOG2E = 1.4426950408889634f;
constexpr float QSCALE = 0.125f * LOG2E;
constexpr float EPS = 1e-6f;

#define LAS __attribute__((address_space(3)))
typedef unsigned short bf16;
typedef short bf16x8 __attribute__((ext_vector_type(8)));
typedef short s16x4 __attribute__((ext_vector_type(4)));
typedef float f32x4 __attribute__((ext_vector_type(4)));
typedef float f32x2 __attribute__((ext_vector_type(2)));
typedef unsigned u32x4 __attribute__((ext_vector_type(4)));
typedef unsigned u32x2 __attribute__((ext_vector_type(2)));
using pg8::cvtpk;

__device__ __forceinline__ float bf_lo(unsigned w) { return __uint_as_float(w << 16); }
__device__ __forceinline__ float bf_hi(unsigned w) { return __uint_as_float(w & 0xffff0000u); }
__device__ __forceinline__ s16x4 tr_read(const LAS unsigned char* p) { return __builtin_bit_cast(s16x4, __builtin_amdgcn_ds_read_tr16_b64_v4i16((LAS s16x4*)p)); }
__device__ __forceinline__ bf16x8 cat8(s16x4 lo, s16x4 hi) { return __builtin_shufflevector(lo, hi, 0, 1, 2, 3, 4, 5, 6, 7); }
#define MFMA16(a, b, c) __builtin_amdgcn_mfma_f32_16x16x32_bf16((a), (b), (c), 0, 0, 0)

constexpr int VP = 144;
constexpr int ATT_WAVE_LDS = 64 * VP + 1040;
__device__ __forceinline__ void att_load_k(bf16x8 (&k)[4][2], const bf16* kb, int fr, int fq) {
#pragma unroll
    for (int kt = 0; kt < 4; ++kt)
#pragma unroll
        for (int ks = 0; ks < 2; ++ks) k[kt][ks] = *(const bf16x8*)(kb + (size_t)(kt * 16 + fr) * PW + ks * 32 + fq * 8);
}
__device__ __forceinline__ void att_load_v(u32x4 (&v)[8], const bf16* vb, int lane) {
#pragma unroll
    for (int i = 0; i < 8; ++i) v[i] = *(const u32x4*)(vb + (size_t)(i * 8 + (lane >> 3)) * PW + (lane & 7) * 8);
}
__device__ __forceinline__ void att_store_v(LAS unsigned char* Vl, const u32x4 (&v)[8], int lane) {
#pragma unroll
    for (int i = 0; i < 8; ++i) *(LAS u32x4*)(Vl + (i * 8 + (lane >> 3)) * VP + (lane & 7) * 16) = v[i];
}
__device__ __forceinline__ void attn_item(const bf16* proj, bf16* mixed, const float* relb, int b, int c, int hg, LAS unsigned char* lds, int wid, int lane) {
    const int h = hg * 4 + (wid >> 1), qh = wid & 1, fr = lane & 15, fq = lane >> 4;
    LAS unsigned char* Vl = lds + wid * ATT_WAVE_LDS;
    LAS float* tb = (LAS float*)(Vl + 64 * VP);
    const size_t tokq = (size_t)b * SEQ + (size_t)c * 64 + qh * 32;
    bf16x8 qf[2][2];
#pragma unroll
    for (int qt = 0; qt < 2; ++qt)
#pragma unroll
        for (int ks = 0; ks < 2; ++ks) qf[qt][ks] = *(const bf16x8*)(proj + (tokq + qt * 16 + fr) * PW + h * 64 + ks * 32 + fq * 8);
    for (int i = lane; i < 257; i += 64) tb[i] = relb[h * 257 + i] * LOG2E;
    float mrun[2] = {-1e30f, -1e30f}, lrun[2] = {0.f, 0.f};
    f32x4 o[4][2];
#pragma unroll
    for (int dt = 0; dt < 4; ++dt)
#pragma unroll
        for (int qt = 0; qt < 2; ++qt) o[dt][qt] = (f32x4){0.f, 0.f, 0.f, 0.f};
    const int j0 = (c < 8) ? 8 - c : 0;
    const bf16* kbase = proj + ((size_t)b * SEQ) * PW + COL_K + h * 64;
    bf16x8 kf[4][2]; u32x4 vn[8];
    { const bf16* kb = kbase + (size_t)(c - 8 + j0) * 64 * PW; att_load_k(kf, kb, fr, fq); att_load_v(vn, kb + (COL_V - COL_K), lane); }
    att_store_v(Vl, vn, lane);
    asm volatile("" ::: "memory");
    const int iq0 = qh * 32 + fr;
    for (int j = j0; j <= 8; ++j) {
        bf16x8 kn[4][2];
        { const int jn = (j < 8) ? j + 1 : 8; const bf16* kb = kbase + (size_t)(c - 8 + jn) * 64 * PW; att_load_k(kn, kb, fr, fq); att_load_v(vn, kb + (COL_V - COL_K), lane); }
        f32x4 s[4][2];
#pragma unroll
        for (int kt = 0; kt < 4; ++kt)
#pragma unroll
            for (int qt = 0; qt < 2; ++qt) { f32x4 a = (f32x4){0.f, 0.f, 0.f, 0.f}; a = MFMA16(kf[kt][0], qf[qt][0], a); a = MFMA16(kf[kt][1], qf[qt][1], a); s[kt][qt] = a; }
        if (j <= 5) { const float bc = tb[256];
#pragma unroll
            for (int kt = 0; kt < 4; ++kt)
#pragma unroll
                for (int qt = 0; qt < 2; ++qt) s[kt][qt] = s[kt][qt] + bc;
        } else { const int cb = 512 - 64 * j;
#pragma unroll
            for (int kt = 0; kt < 4; ++kt)
#pragma unroll
                for (int qt = 0; qt < 2; ++qt)
#pragma unroll
                    for (int r = 0; r < 4; ++r) { int rel = (iq0 + qt * 16) - (kt * 16 + 4 * fq + r) + cb; rel = rel < -128 ? -128 : (rel > 128 ? 128 : rel); s[kt][qt][r] += tb[rel + 128]; }
        }
        bf16x8 pf[2][2];
#pragma unroll
        for (int qt = 0; qt < 2; ++qt) {
            float mx = s[0][qt][0];
#pragma unroll
            for (int kt = 0; kt < 4; ++kt)
#pragma unroll
                for (int r = 0; r < 4; ++r) mx = fmaxf(mx, s[kt][qt][r]);
            mx = fmaxf(mx, __shfl_xor(mx, 16)); mx = fmaxf(mx, __shfl_xor(mx, 32));
            const float mn = fmaxf(mrun[qt], mx), al = __builtin_amdgcn_exp2f(mrun[qt] - mn); mrun[qt] = mn;
            float ps = 0.f;
#pragma unroll
            for (int kt = 0; kt < 4; ++kt)
#pragma unroll
                for (int r = 0; r < 4; ++r) { const float p = __builtin_amdgcn_exp2f(s[kt][qt][r] - mn); s[kt][qt][r] = p; ps += p; }
            lrun[qt] = lrun[qt] * al + ps;
#pragma unroll
            for (int dt = 0; dt < 4; ++dt) o[dt][qt] = o[dt][qt] * al;
#pragma unroll
            for (int s2 = 0; s2 < 2; ++s2) { u32x4 w; w.x = cvtpk(s[2 * s2][qt][0], s[2 * s2][qt][1]); w.y = cvtpk(s[2 * s2][qt][2], s[2 * s2][qt][3]);
                w.z = cvtpk(s[2 * s2 + 1][qt][0], s[2 * s2 + 1][qt][1]); w.w = cvtpk(s[2 * s2 + 1][qt][2], s[2 * s2 + 1][qt][3]); pf[qt][s2] = __builtin_bit_cast(bf16x8, w); }
        }
        const LAS unsigned char* vrd = Vl + (4 * fq + (fr >> 2)) * VP + (lane & 3) * 8;
#pragma unroll
        for (int s2 = 0; s2 < 2; ++s2)
#pragma unroll
            for (int dt = 0; dt < 4; ++dt) {
                const s16x4 lo = tr_read(vrd + (32 * s2) * VP + dt * 32), hi = tr_read(vrd + (32 * s2 + 16) * VP + dt * 32);
                const bf16x8 vf = cat8(lo, hi);
#pragma unroll
                for (int qt = 0; qt < 2; ++qt) o[dt][qt] = MFMA16(vf, pf[qt][s2], o[dt][qt]);
            }
        asm volatile("" ::: "memory");
        att_store_v(Vl, vn, lane);
        asm volatile("" ::: "memory");
#pragma unroll
        for (int kt = 0; kt < 4; ++kt)
#pragma unroll
            for (int ks = 0; ks < 2; ++ks) kf[kt][ks] = kn[kt][ks];
    }
#pragma unroll
    for (int qt = 0; qt < 2; ++qt) {
        float l = lrun[qt]; l += __shfl_xor(l, 16); l += __shfl_xor(l, 32);
        const float inv = 1.0f / l; float q = 0.f;
#pragma unroll
        for (int dt = 0; dt < 4; ++dt) { o[dt][qt] = o[dt][qt] * inv; const f32x4 v = o[dt][qt]; q += (v[0] * v[0] + v[1] * v[1]) + (v[2] * v[2] + v[3] * v[3]); }
        q += __shfl_xor(q, 16); q += __shfl_xor(q, 32);
        const float rs = __builtin_amdgcn_rsqf(q * (1.0f / 64.0f) + EPS);
        bf16* op = mixed + (tokq + qt * 16 + fr) * DM + h * 64 + 4 * fq;
#pragma unroll
        for (int dt = 0; dt < 4; ++dt) { const f32x4 v = o[dt][qt] * rs; u32x2 w; w.x = cvtpk(v[0], v[1]); w.y = cvtpk(v[2], v[3]); *(u32x2*)(op + dt * 16) = w; }
    }
}

__device__ __forceinline__ void unpack8(float (&f)[8], u32x4 w) { f[0] = bf_lo(w.x); f[1] = bf_hi(w.x); f[2] = bf_lo(w.y); f[3] = bf_hi(w.y); f[4] = bf_lo(w.z); f[5] = bf_hi(w.z); f[6] = bf_lo(w.w); f[7] = bf_hi(w.w); }
__device__ __forceinline__ void conv_item(const bf16* proj, bf16* mixed, const float* cw, int item, int tid) {
    const int oc = tid & 31, c0 = oc * 8;
    float w0[8], w1[8], w2[8];
#pragma unroll
    for (int i = 0; i < 8; ++i) { w0[i] = cw[c0 + i]; w1[i] = cw[256 + c0 + i]; w2[i] = cw[512 + c0 + i]; }
#pragma unroll 1
    for (int pass = 0; pass < 4; ++pass) {
        const int t = item * 64 + pass * 16 + (tid >> 5), ts = t & (SEQ - 1);
        const bf16* rp = proj + (size_t)t * PW + c0;
        float bg[8], z[8], y[8], a[8], x[8];
        unpack8(bg, *(const u32x4*)(rp + COL_BG));
        unpack8(a, *(const u32x4*)(rp + COL_CG)); unpack8(x, *(const u32x4*)(rp + COL_XH));
#pragma unroll
        for (int i = 0; i < 8; ++i) y[i] = w2[i] * (a[i] * x[i]);
        if (ts >= 1) { unpack8(a, *(const u32x4*)(rp - PW + COL_CG)); unpack8(x, *(const u32x4*)(rp - PW + COL_XH));
#pragma unroll
            for (int i = 0; i < 8; ++i) y[i] += w1[i] * (a[i] * x[i]); }
        if (ts >= 2) { unpack8(a, *(const u32x4*)(rp - 2 * PW + COL_CG)); unpack8(x, *(const u32x4*)(rp - 2 * PW + COL_XH));
#pragma unroll
            for (int i = 0; i < 8; ++i) y[i] += w0[i] * (a[i] * x[i]); }
        float q = 0.f;
#pragma unroll
        for (int i = 0; i < 8; ++i) { z[i] = bg[i] * y[i]; q += z[i] * z[i]; }
        q += __shfl_xor(q, 1); q += __shfl_xor(q, 2); q += __shfl_xor(q, 4);
        const float rs = __builtin_amdgcn_rsqf(q * (1.0f / 64.0f) + EPS);
        u32x4 w; w.x = cvtpk(z[0] * rs, z[1] * rs); w.y = cvtpk(z[2] * rs, z[3] * rs); w.z = cvtpk(z[4] * rs, z[5] * rs); w.w = cvtpk(z[6] * rs, z[7] * rs);
        *(u32x4*)(mixed + (size_t)t * DM + 512 + c0) = w;
    }
}

constexpr int GP = 544;
__device__ __forceinline__ void gate_item(const bf16* proj, bf16* mixed, const float* lng, const float* lnb, const bf16* wsb, const float* sgb, int blk, LAS unsigned char* lds, int tid, int wid, int lane) {
    const size_t tok0 = (size_t)blk * 128;
    { const int tk = tid >> 2, part = tid & 3;
        const bf16* rp = proj + (tok0 + tk) * PW + COL_SV + part * 64;
        float x[64];
#pragma unroll
        for (int i = 0; i < 8; ++i) { float f[8]; unpack8(f, *(const u32x4*)(rp + i * 8));
#pragma unroll
            for (int k = 0; k < 8; ++k) x[i * 8 + k] = f[k]; }
        float sm = 0.f;
#pragma unroll
        for (int i = 0; i < 64; ++i) sm += x[i];
        sm += __shfl_xor(sm, 1); sm += __shfl_xor(sm, 2);
        const float mu = sm * (1.0f / 256.0f); float q = 0.f;
#pragma unroll
        for (int i = 0; i < 64; ++i) { x[i] -= mu; q += x[i] * x[i]; }
        q += __shfl_xor(q, 1); q += __shfl_xor(q, 2);
        const float rs = __builtin_amdgcn_rsqf(q * (1.0f / 256.0f) + EPS);
        LAS unsigned char* wp = lds + tk * GP + part * 128;
#pragma unroll
        for (int i = 0; i < 8; ++i) { const f32x4 g0 = *(const f32x4*)(lng + part * 64 + i * 8), g1 = *(const f32x4*)(lng + part * 64 + i * 8 + 4), b0 = *(const f32x4*)(lnb + part * 64 + i * 8), b1 = *(const f32x4*)(lnb + part * 64 + i * 8 + 4);
            u32x4 w; w.x = cvtpk(x[i * 8 + 0] * rs * g0[0] + b0[0], x[i * 8 + 1] * rs * g0[1] + b0[1]); w.y = cvtpk(x[i * 8 + 2] * rs * g0[2] + b0[2], x[i * 8 + 3] * rs * g0[3] + b0[3]);
            w.z = cvtpk(x[i * 8 + 4] * rs * g1[0] + b1[0], x[i * 8 + 5] * rs * g1[1] + b1[1]); w.w = cvtpk(x[i * 8 + 6] * rs * g1[2] + b1[2], x[i * 8 + 7] * rs * g1[3] + b1[3]);
            *(LAS u32x4*)(wp + i * 16) = w; }
    }
    __syncthreads();
    {
        const int g = wid >> 1, th = wid & 1, fr = lane & 15, fq = lane >> 4;
        f32x4 acc[4][4];
#pragma unroll
        for (int ct = 0; ct < 4; ++ct)
#pragma unroll
            for (int tt = 0; tt < 4; ++tt) acc[ct][tt] = (f32x4){0.f, 0.f, 0.f, 0.f};
        const int nks = th ? 4 : 2;
        const LAS unsigned char* vrd = lds + (8 * fq + (fr >> 2)) * GP + g * 128 + (lane & 3) * 8;
        const bf16* wrow = wsb + ((size_t)g * 128 + th * 64 + fr) * 128 + 8 * fq;
#pragma unroll 1
        for (int ks = 0; ks < nks; ++ks) {
            bf16x8 vf[4];
#pragma unroll
            for (int ct = 0; ct < 4; ++ct) { const s16x4 lo = tr_read(vrd + (32 * ks) * GP + ct * 32), hi = tr_read(vrd + (32 * ks + 4) * GP + ct * 32); vf[ct] = cat8(lo, hi); }
#pragma unroll
            for (int tt = 0; tt < 4; ++tt) { const bf16x8 wf = *(const bf16x8*)(wrow + (size_t)(tt * 16) * 128 + ks * 32);
#pragma unroll
                for (int ct = 0; ct < 4; ++ct) acc[ct][tt] = MFMA16(vf[ct], wf, acc[ct][tt]); }
        }
#pragma unroll
        for (int tt = 0; tt < 4; ++tt) { const int t = th * 64 + tt * 16 + fr; const float bias = sgb[g * 128 + t];
            const bf16* up = proj + (tok0 + t) * PW + COL_SU + g * 64 + 4 * fq; float q = 0.f; f32x4 v[4];
#pragma unroll
            for (int ct = 0; ct < 4; ++ct) { const u32x2 uw = *(const u32x2*)(up + ct * 16); const f32x4 uu = (f32x4){bf_lo(uw.x), bf_hi(uw.x), bf_lo(uw.y), bf_hi(uw.y)};
                v[ct] = uu * (acc[ct][tt] + bias); q += (v[ct][0] * v[ct][0] + v[ct][1] * v[ct][1]) + (v[ct][2] * v[ct][2] + v[ct][3] * v[ct][3]); }
            q += __shfl_xor(q, 16); q += __shfl_xor(q, 32);
            const float rs = __builtin_amdgcn_rsqf(q * (1.0f / 64.0f) + EPS);
            bf16* op = mixed + (tok0 + t) * DM + 768 + g * 64 + 4 * fq;
#pragma unroll
            for (int ct = 0; ct < 4; ++ct) { const f32x4 r = v[ct] * rs; u32x2 w; w.x = cvtpk(r[0], r[1]); w.y = cvtpk(r[2], r[3]); *(u32x2*)(op + ct * 16) = w; }
        }
    }
    __syncthreads();
}

constexpr size_t MiB = 1u << 20;
constexpr size_t SZ_WIN = (size_t)PW * DM * 2, SZ_WOUT = (size_t)DM * DM * 2, SZ_WUP = (size_t)DFF * DM * 2, SZ_WDN = (size_t)DM * DFF * 2, SZ_WSG = (size_t)4 * 128 * 128 * 2;
constexpr size_t WS_WIN = 0;
constexpr size_t WS_WOUT = WS_WIN + DEPTH * SZ_WIN;
constexpr size_t WS_WUP = WS_WOUT + DEPTH * SZ_WOUT;
constexpr size_t WS_WDN = WS_WUP + DEPTH * SZ_WUP;
constexpr size_t WS_WSG = WS_WDN + DEPTH * SZ_WDN;
constexpr size_t WS_SS = WS_WSG + DEPTH * SZ_WSG;
constexpr size_t WS_XB = WS_SS + (size_t)M_TOK * 16 * 4;
constexpr size_t WS_PROJ = WS_XB + (size_t)M_TOK * DM * 2;
constexpr size_t WS_MIX = WS_PROJ + (size_t)M_TOK * PW * 2;
constexpr size_t WS_HDN = WS_PROJ;
constexpr size_t WS_CTL = WS_HDN + (size_t)M_TOK * DFF * 2, CTL_BYTES = 65536;
constexpr size_t WS_END = WS_CTL + CTL_BYTES;
static_assert(WS_MIX + (size_t)M_TOK * DM * 2 <= WS_CTL, "hdn covers proj + mixed");
static_assert(WS_WOUT % 256 == 0 && WS_WUP % 256 == 0 && WS_WDN % 256 == 0 && WS_WSG % 256 == 0 && WS_SS % 256 == 0 && WS_XB % 256 == 0 && WS_PROJ % 256 == 0 && WS_MIX % 256 == 0, "alignment");

constexpr int NWAVES = 8;
constexpr int LDS_BYTES = 132096;
static_assert(8 * ATT_WAVE_LDS <= 131072 && 128 * GP <= 131072, "LDS map");

#define XB_TMO      128
#define XB_XCNT(j)  (256  + 64 * (j))
#define XB_XSUB(j)  (1280 + 64 * (j))
#define XB_XGEN(j)  (2304 + 64 * (j))
#define XB_TOP      3328
#define XB_TOPGEN   3392
#define XCD_BAR_WORDS 3456
#define XB_SPIN_CAP (1u << 18)

__device__ __forceinline__ unsigned xb_ld(unsigned* p)              { return __hip_atomic_load(p, __ATOMIC_RELAXED, __HIP_MEMORY_SCOPE_AGENT); }
__device__ __forceinline__ unsigned xb_add(unsigned* p, unsigned v) { return __hip_atomic_fetch_add(p, v, __ATOMIC_RELAXED, __HIP_MEMORY_SCOPE_AGENT); }
__device__ __forceinline__ unsigned xb_xcc_id() { return (unsigned)__builtin_amdgcn_s_getreg((3 << 11) | 20) & 0xFu; }
#define XB_SPIN(cond, bar) do { unsigned _sp = 0; while (cond) { __builtin_amdgcn_s_sleep(1); \
    if ((++_sp & 255u) == 0u) { if (xb_ld(&(bar)[XB_TMO])) break; if (_sp > XB_SPIN_CAP) { atomicAdd(&(bar)[XB_TMO], 1u); break; } } } } while (0)

struct XcdBarrier {
    unsigned* bar; unsigned x;
    volatile LAS unsigned* st;
};

__device__ __forceinline__ XcdBarrier xcd_barrier_post(unsigned* bar, volatile LAS unsigned* st) {
    XcdBarrier b; b.bar = bar; b.x = xb_xcc_id(); b.st = st;
    if (threadIdx.x == 0) (void)xb_add(&bar[XB_XCNT(b.x)], 1u);
    return b;
}
__device__ __forceinline__ void xcd_barrier_complete(unsigned* bar, unsigned x, unsigned& nloc, unsigned& nx) {
    const unsigned G = gridDim.x * gridDim.y * gridDim.z;
    unsigned sum, cnt, mine, sp = 0u;
    for (;;) {
        sum = 0u; cnt = 0u; mine = 0u;
#pragma unroll
        for (unsigned j = 0; j < 16; ++j) { const unsigned c = xb_ld(&bar[XB_XCNT(j)]); sum += c; cnt += (c > 0u) ? 1u : 0u; mine = (j == x) ? c : mine; }
        if (sum == G) break;
        __builtin_amdgcn_s_sleep(1);
        if ((++sp & 255u) == 0u) { if (xb_ld(&bar[XB_TMO])) break; if (sp > XB_SPIN_CAP) { atomicAdd(&bar[XB_TMO], 1u); break; } }
    }
    nloc = mine > 0u ? mine : 1u; nx = cnt > 0u ? cnt : 1u;
}

__device__ __forceinline__ void xcd_barrier(const XcdBarrier& b) {
    asm volatile("s_waitcnt vmcnt(0)" ::: "memory");
    __syncthreads();
    if (threadIdx.x == 0) {
        unsigned* bar = b.bar;
        __builtin_amdgcn_s_waitcnt(0);
        unsigned nloc = b.st[0], nx = b.st[1];
        if (nloc == 0u) { xcd_barrier_complete(bar, b.x, nloc, nx); b.st[0] = nloc; b.st[1] = nx; }
        const unsigned old = xb_add(&bar[XB_XSUB(b.x)], 1u);
        const unsigned gen = old / nloc;
        if (old + 1u == (gen + 1u) * nloc) {
            __builtin_amdgcn_fence(__ATOMIC_RELEASE, "agent");
            asm volatile("s_waitcnt vmcnt(0)" ::: "memory");
            const unsigned og = xb_add(&bar[XB_TOP], 1u);
            const unsigned tg = og / nx;
            if (og + 1u == (tg + 1u) * nx) xb_add(&bar[XB_TOPGEN], 1u);
            else XB_SPIN(xb_ld(&bar[XB_TOPGEN]) == tg, bar);
            __builtin_amdgcn_fence(__ATOMIC_ACQUIRE, "agent");
            xb_add(&bar[XB_XGEN(b.x)], 1u);
            asm volatile("s_waitcnt vmcnt(0)" ::: "memory");
        } else {
            XB_SPIN(xb_ld(&bar[XB_XGEN(b.x)]) == gen, bar);
            __builtin_amdgcn_fence(__ATOMIC_ACQUIRE, "agent");
            asm volatile("s_waitcnt vmcnt(0)" ::: "memory");
        }
    }
    __syncthreads();
}

__device__ __forceinline__ unsigned f2bf(float f) { unsigned u = __builtin_bit_cast(unsigned, f); return (u + 0x7fffu + ((u >> 16) & 1u)) >> 16; }
__device__ __forceinline__ unsigned pk2(float lo, float hi) { return f2bf(lo) | (f2bf(hi) << 16); }
__device__ __forceinline__ float wave_sum(float v) {
#pragma unroll
    for (int o = 1; o < 64; o <<= 1) v += __shfl_xor(v, o);
    return v;
}
__device__ __forceinline__ void p0_transpose_item(const float* W, const float* gain, int K, int N, bf16* WT, LAS float* scr, int item, int lane) {
    const int nblk = N / 32, kb = item / nblk, nb = item % nblk, k0 = 64 * kb, n0 = 32 * nb;
#pragma unroll 8
    for (int i = 0; i < 32; ++i) { const int kk = 2 * i + (lane >> 5); const float gsc = gain ? gain[k0 + kk] : 1.0f; scr[kk * 33 + (lane & 31)] = W[(size_t)(k0 + kk) * N + n0 + (lane & 31)] * gsc; }
    asm volatile("s_waitcnt lgkmcnt(0)" ::: "memory");
    const int c = lane & 7;
#pragma unroll
    for (int j = 0; j < 4; ++j) { const int n = (lane >> 3) + 8 * j; const LAS float* s = scr + (8 * c) * 33 + n;
        u32x4 o; o.x = pk2(s[0 * 33], s[1 * 33]); o.y = pk2(s[2 * 33], s[3 * 33]); o.z = pk2(s[4 * 33], s[5 * 33]); o.w = pk2(s[6 * 33], s[7 * 33]);
        *(u32x4*)(WT + (size_t)(n0 + n) * K + k0 + 8 * c) = o; }
    asm volatile("s_waitcnt lgkmcnt(0)" ::: "memory");
}

struct Args { const float* in[15]; float* out; unsigned char* ws; };

__global__ void __launch_bounds__(NWAVES * 64, 2) trunk_fwd(Args args) {
    extern __shared__ __attribute__((aligned(16))) unsigned char lds_raw[];
    cg::grid_group grid = cg::this_grid();
    LAS unsigned char* lds = (LAS unsigned char*)lds_raw;
    const int G = gridDim.x, bx = blockIdx.x;
    const int vcu = (G % 8 == 0) ? (bx % 8) * (G / 8) + bx / 8 : bx;
    unsigned char* ws = args.ws;
    if (threadIdx.x < 64) ((LAS unsigned*)(lds + 131072))[threadIdx.x] = 0u;
    __syncthreads();
    const XcdBarrier bar = xcd_barrier_post((unsigned*)(ws + WS_CTL), (volatile LAS unsigned*)(lds + 131072));
    const float* x_in = args.in[0];
    float* X = args.out;
    bf16* XB = (bf16*)(ws + WS_XB); float* SS = (float*)(ws + WS_SS);
    bf16* PROJ = (bf16*)(ws + WS_PROJ); bf16* MIXB = (bf16*)(ws + WS_MIX); bf16* HDN = (bf16*)(ws + WS_HDN);

    {
        int tid = threadIdx.x; asm volatile("" : "+v"(tid)); const int lane = tid & 63, wid = __builtin_amdgcn_readfirstlane(tid >> 6);
        LAS float* scr = (LAS float*)(lds + wid * 16384);
        const int gw = vcu * NWAVES + wid, NGW = G * NWAVES;
        constexpr int I_IN = (DM / 64) * (PW / 32), I_OUT = (DM / 64) * (DM / 32), I_UP = (DM / 64) * (DFF / 32), I_DN = (DFF / 64) * (DM / 32), I_L = I_IN + I_OUT + I_UP + I_DN;
        for (int it = gw; it < DEPTH * I_L; it += NGW) {
            const int l = it / I_L; int r = it % I_L;
            if (r < I_IN) { p0_transpose_item(args.in[2] + (size_t)l * DM * PW, args.in[1] + l * DM, DM, PW, (bf16*)(ws + WS_WIN + l * SZ_WIN), scr, r, lane); continue; } r -= I_IN;
            if (r < I_OUT) { p0_transpose_item(args.in[10] + (size_t)l * DM * DM, args.in[9] + l * DM, DM, DM, (bf16*)(ws + WS_WOUT + l * SZ_WOUT), scr, r, lane); continue; } r -= I_OUT;
            if (r < I_UP) { p0_transpose_item(args.in[12] + (size_t)l * DM * DFF, args.in[11] + l * DM, DM, DFF, (bf16*)(ws + WS_WUP + l * SZ_WUP), scr, r, lane); continue; } r -= I_UP;
            p0_transpose_item(args.in[13] + (size_t)l * DFF * DM, nullptr, DFF, DM, (bf16*)(ws + WS_WDN + l * SZ_WDN), scr, r, lane);
        }
        { const float* sw = args.in[7]; bf16* wsg = (bf16*)(ws + WS_WSG);
            for (int i = bx * 512 + tid; i < DEPTH * 4 * 128 * 128 / 2; i += G * 512) { const int e = 2 * i, t = (e >> 7) & 127, s = e & 127; const f32x2 v = *(const f32x2*)(sw + e);
                ((unsigned*)wsg)[i] = pk2(s <= t ? v.x : 0.f, (s + 1) <= t ? v.y : 0.f); } }
        for (int m = gw; m < M_TOK; m += NGW) {
            const f32x4* xr = (const f32x4*)(x_in + (size_t)m * DM) + lane; unsigned long long* o8 = (unsigned long long*)(XB + (size_t)m * DM) + lane; float q = 0.f;
#pragma unroll
            for (int j = 0; j < 4; ++j) { const f32x4 v = xr[64 * j]; q += (v.x * v.x + v.y * v.y) + (v.z * v.z + v.w * v.w); o8[64 * j] = (unsigned long long)pk2(v.x, v.y) | ((unsigned long long)pk2(v.z, v.w) << 32); }
            q = wave_sum(q);
            if (lane < 16) SS[(size_t)m * 16 + lane] = (lane == 0) ? q : 0.f;
        }
    }
    grid.sync();

#pragma unroll 1
    for (int l = 0; l < DEPTH; ++l) {
        {
            pg8::Gemm g{XB, (const bf16*)(ws + WS_WIN + l * SZ_WIN), M_TOK, PW, DM}; pg8::StaticOrder S; S.init(M_TOK, PW, G, bx);
            pg8::EpiAct<0, PW> E{PROJ, SS, QSCALE};
            pg8::gemm_phase<pg8::EpiAct<0, PW>, pg8::StaticOrder, true, true>(lds, g, S, E);
        }
        xcd_barrier(bar);
#ifndef REP_P2
#define REP_P2 1
#endif
#pragma unroll 1
        for (int rep = 0; rep < REP_P2; ++rep) {
            int tid = threadIdx.x; asm volatile("" : "+v"(tid));
            const int lane = tid & 63, wid = __builtin_amdgcn_readfirstlane(tid >> 6);
            const float* relb = args.in[3] + (size_t)l * 8 * 257;
            for (int u = vcu; u < BATCH * 2 * NCHUNK; u += G) { const int c = u % NCHUNK, bh = u / NCHUNK; attn_item(PROJ, MIXB, relb, bh >> 1, c, bh & 1, lds, wid, lane); }
            for (int u = bx; u < M_TOK / 64; u += G) conv_item(PROJ, MIXB, args.in[4] + (size_t)l * 3 * 256, u, tid);
            __syncthreads();
            for (int u = bx; u < M_TOK / 128; u += G)
                gate_item(PROJ, MIXB, args.in[5] + l * 256, args.in[6] + l * 256, (const bf16*)(ws + WS_WSG + l * SZ_WSG), args.in[8] + l * 512, u, lds, tid, wid, lane);
        }
        xcd_barrier(bar);
        {
            pg8::Gemm g{MIXB, (const bf16*)(ws + WS_WOUT + l * SZ_WOUT), M_TOK, DM, DM}; pg8::StaticOrder S; S.init(M_TOK, DM, G, bx);
            pg8::EpiRes E{l == 0 ? x_in : (const float*)X, X, XB, SS};
            pg8::gemm_phase<pg8::EpiRes, pg8::StaticOrder, true, true>(lds, g, S, E);
        }
        xcd_barrier(bar);
        {
            pg8::Gemm g{XB, (const bf16*)(ws + WS_WUP + l * SZ_WUP), M_TOK, DFF, DM}; pg8::StaticOrder S; S.init(M_TOK, DFF, G, bx);
            pg8::EpiAct<1, DFF> E{HDN, SS, 1.0f};
            pg8::gemm_phase<pg8::EpiAct<1, DFF>, pg8::StaticOrder, true, true>(lds, g, S, E);
        }
        xcd_barrier(bar);
        {
            pg8::Gemm g{HDN, (const bf16*)(ws + WS_WDN + l * SZ_WDN), M_TOK, DM, DFF}; pg8::StaticOrder S; S.init(M_TOK, DM, G, bx);
            pg8::EpiRes E{X, X, XB, SS};
            pg8::gemm_phase<pg8::EpiRes, pg8::StaticOrder, true, true>(lds, g, S, E);
        }
        xcd_barrier(bar);
    }
    {
        int tidf = threadIdx.x; asm volatile("" : "+v"(tidf)); const int lane = tidf & 63, wid = __builtin_amdgcn_readfirstlane(tidf >> 6);
        const int gw = vcu * NWAVES + wid, NGW = G * NWAVES; const f32x4* gp = (const f32x4*)args.in[14] + lane;
        for (int m = gw; m < M_TOK; m += NGW) {
            f32x4* xr = (f32x4*)(X + (size_t)m * DM) + lane; f32x4 v[4]; float q = 0.f;
#pragma unroll
            for (int j = 0; j < 4; ++j) { v[j] = xr[64 * j]; q += (v[j].x * v[j].x + v[j].y * v[j].y) + (v[j].z * v[j].z + v[j].w * v[j].w); }
            const float rs = 1.0f / sqrtf(wave_sum(q) * (1.0f / DM) + EPS);
#pragma unroll
            for (int j = 0; j < 4; ++j) xr[64 * j] = v[j] * rs * gp[64 * j];
        }
    }
}

extern "C" void kernel_launch(void* const* d_in, const int* in_sizes, int n_in, void* d_out, int out_size, void* d_ws, size_t ws_size, hipStream_t stream) {
    static int grid = 0;
    if (grid == 0) {
        if (n_in != 15 || in_sizes[0] != M_TOK * DM || out_size != M_TOK * DM || ws_size < WS_END) { fprintf(stderr, "kernel_launch: unexpected shapes (n_in %d, in0 %d, out %d, ws %zu < %zu); nothing launched\n", n_in, n_in > 0 ? in_sizes[0] : -1, out_size, ws_size, (size_t)WS_END); grid = -1; return; }
        int dev = 0, cus = 0, per_cu = 0;
        if (hipGetDevice(&dev) != hipSuccess || hipDeviceGetAttribute(&cus, hipDeviceAttributeMultiprocessorCount, dev) != hipSuccess) { grid = -1; return; }
        if (hipFuncSetAttribute((const void*)trunk_fwd, hipFuncAttributeMaxDynamicSharedMemorySize, LDS_BYTES) != hipSuccess) { fprintf(stderr, "kernel_launch: hipFuncSetAttribute failed\n"); grid = -1; return; }
        if (hipOccupancyMaxActiveBlocksPerMultiprocessor(&per_cu, (const void*)trunk_fwd, NWAVES * 64, LDS_BYTES) != hipSuccess || per_cu < 1) { fprintf(stderr, "kernel_launch: occupancy query says %d blocks per CU\n", per_cu); per_cu = 1; }
        (void)hipGetLastError();
        grid = cus * per_cu;
    }
    if (grid < 0) return;
    if (hipMemsetAsync((char*)d_ws + WS_CTL, 0, CTL_BYTES, stream) != hipSuccess) { fprintf(stderr, "kernel_launch: memset failed\n"); return; }
    Args a{};
    for (int i = 0; i < 15; ++i) a.in[i] = (const float*)d_in[i];
    a.out = (float*)d_out; a.ws = (unsigned char*)d_ws;
    void* kargs[] = {&a};
    hipError_t e = hipLaunchCooperativeKernel((const void*)trunk_fwd, dim3(grid), dim3(NWAVES * 64), kargs, LDS_BYTES, stream);
    if (e != hipSuccess) fprintf(stderr, "kernel_launch: cooperative launch failed: %s (grid %d)\n", hipGetErrorString(e), grid);
}
```

```cpp
#include <hip/hip_runtime.h>
#include <hip/hip_cooperative_groups.h>
#include <cstdio>
#include <cstdint>
namespace cg = cooperative_groups;
namespace pg8 {
#define PG8_LAS __attribute__((address_space(3)))
typedef unsigned short bf16_t;
typedef short bf16x8 __attribute__((ext_vector_type(8)));
typedef float f32x4 __attribute__((ext_vector_type(4)));
typedef unsigned u32x4 __attribute__((ext_vector_type(4)));
constexpr int BM = 256, BK = 64, HALF = 128, HTB = HALF * BK * 2  , STAGE_BYTES = 8 * HTB, NXCD = 8, WGM = 8;

__host__ __device__ __forceinline__ int lds_byte(int r, int c) { const int st = (r >> 4) * 2 + (c >> 5), rr = r & 15, cc = c & 31, ob = rr * 64 + cc * 2; return st * 1024 + (ob ^ (((ob >> 9) & 1) << 5)); }
__host__ __device__ __forceinline__ void stage_rc(int b, int& R, int& C) { const int st = b / 1024, sb = b % 1024, swz = sb ^ (((sb >> 9) & 1) << 5); R = (st >> 1) * 16 + swz / 64; C = (st & 1) * 32 + (swz % 64) / 2; }
__host__ __device__ __forceinline__ int perm32(int rho) { const int n = rho >> 4, i = rho & 15; return 8 * (i >> 2) + 4 * n + (i & 3); }

struct Unit { int pm, pn; };
struct Gemm { const bf16_t* A; const bf16_t* Bt; int M, N, K; };

struct StaticOrder {
    int nM, nN, nwg, G, c;
    __host__ __device__ void init(int M, int N, int G_, int c_) { nM = M / BM; nN = N / BM; nwg = nM * nN; G = G_; c = c_; }
    __host__ __device__ bool next(int i, Unit& u) const {
        const long L = (long)i * G + c; if (L >= nwg) return false;
        int wgid = (int)L; { const int q = nwg / NXCD, r = nwg % NXCD, xcd = wgid % NXCD, off = wgid / NXCD; wgid = (xcd < r ? xcd * (q + 1) : r * (q + 1) + (xcd - r) * q) + off; }
        const int nig = WGM * nN, gid = wgid / nig, fm = gid * WGM, gsz = (nM - fm) < WGM ? (nM - fm) : WGM;
        u.pm = fm + ((wgid % nig) % gsz); u.pn = (wgid % nig) / gsz; return true;
    }
    __device__ __forceinline__ void a_ready(const Unit&) const {}
    __device__ __forceinline__ void done(const Unit&) const {}
};

__device__ __forceinline__ unsigned cvt_pk_bf16(float lo, float hi) { unsigned r; asm volatile("v_cvt_pk_bf16_f32 %0, %1, %2" : "=v"(r) : "v"(lo), "v"(hi)); return r; }
typedef float f32x2 __attribute__((ext_vector_type(2)));
__device__ __forceinline__ f32x2 gelu_pk(f32x2 v) {
    const f32x2 av = __builtin_elementwise_abs(v), d = av * 0.2316418882f + 1.0f;
    f32x2 t; t.x = __builtin_amdgcn_rcpf(d.x); t.y = __builtin_amdgcn_rcpf(d.y);
    f32x2 q = t * 0.5307027145f + (-0.7265760135f); q = q * t + 0.7107068705f; q = q * t + (-0.142248368f); q = q * t + 0.127414796f; q = q * t;
    const f32x2 s = (v * v) * (-0.72134752044f);
    f32x2 e; e.x = __builtin_amdgcn_exp2f(s.x); e.y = __builtin_amdgcn_exp2f(s.y);
    const f32x2 m = v * (q * e), r = v - m;
    f32x2 o; o.x = v.x < 0.f ? m.x : r.x; o.y = v.y < 0.f ? m.y : r.y; return o;
}


typedef unsigned u32x2 __attribute__((ext_vector_type(2)));
typedef __bf16 bf16x2_t __attribute__((ext_vector_type(2)));
__device__ __forceinline__ unsigned cvtpk(float lo, float hi) { f32x2 v = {lo, hi}; bf16x2_t b = __builtin_convertvector(v, bf16x2_t); return __builtin_bit_cast(unsigned, b); }
constexpr float RMS_EPS = 1e-6f;
__device__ __forceinline__ float row_rstd(const char* rec) {
    const f32x4* p = (const f32x4*)rec;
    const f32x4 a = p[0], b = p[1], c = p[2], d = p[3];
    const f32x4 s = (a + b) + (c + d);
    const float t = (s[0] + s[1]) + (s[2] + s[3]);
    return __builtin_amdgcn_rsqf(t * (1.0f / 1024.0f) + RMS_EPS);
}
template <int MODE, int LDC> struct EpiAct {
    static constexpr bool PERM = true, AFTER_DRAIN = false;
    bf16_t* O; const float* ss; float qscale;
    __device__ __forceinline__ void operator()(const f32x4 (&acc)[2][2][4][2], const Unit& u, int wr, int wc, int fr, int fq) const {
        const int rl = wr * 64 + fr;
        unsigned ooff = (unsigned)(rl * LDC + wc * 32 + 8 * fq) * 2u, soff = (unsigned)rl * 64u;
        asm volatile("" : "+v"(ooff), "+v"(soff));
        char* obase = (char*)O + ((size_t)u.pm * BM * LDC + (size_t)u.pn * BM) * 2;
        const char* sbase = (const char*)ss + (size_t)u.pm * BM * 64;
        const float sc = (MODE == 0 && u.pn < 2) ? qscale : 1.0f; const bool act = (MODE == 0 && u.pn >= 9);
#pragma unroll
        for (int ai = 0; ai < 2; ++ai)
#pragma unroll
            for (int m = 0; m < 4; ++m) { const int ro = ai * HALF + m * 16; const float rs = row_rstd(sbase + soff + ro * 64) * sc; char* rowp = obase + ooff + (size_t)ro * LDC * 2;
#pragma unroll
                for (int bj = 0; bj < 2; ++bj) { f32x4 v0 = acc[ai][bj][m][0] * rs, v1 = acc[ai][bj][m][1] * rs;
                    if (MODE == 0) { if (act) { f32x2 a = gelu_pk((f32x2){v0[0], v0[1]}), b = gelu_pk((f32x2){v0[2], v0[3]}), c = gelu_pk((f32x2){v1[0], v1[1]}), d = gelu_pk((f32x2){v1[2], v1[3]});
                        v0 = (f32x4){a.x, a.y, b.x, b.y}; v1 = (f32x4){c.x, c.y, d.x, d.y}; } }
                    else { v0 = __builtin_elementwise_max(v0, (f32x4){0.f, 0.f, 0.f, 0.f}); v1 = __builtin_elementwise_max(v1, (f32x4){0.f, 0.f, 0.f, 0.f}); v0 = v0 * v0; v1 = v1 * v1; }
                    u32x4 w; w.x = cvtpk(v0[0], v0[1]); w.y = cvtpk(v0[2], v0[3]); w.z = cvtpk(v1[0], v1[1]); w.w = cvtpk(v1[2], v1[3]);
                    *(u32x4*)(rowp + bj * HALF * 2) = w; } }
    }
};
struct EpiRes {
    static constexpr bool PERM = false, AFTER_DRAIN = false;
    bf16_t* xb; float* ss;
    __device__ __forceinline__ void operator()(const f32x4 (&acc)[2][2][4][2], const Unit& u, int wr, int wc, int fr, int fq) const {
        const int rl = wr * 64 + fr;
        unsigned eoff = (unsigned)(rl * 1024 + wc * 32 + 4 * fq) * 2u, soff = (unsigned)(rl * 16 + wc) * 4u;
        asm volatile("" : "+v"(eoff), "+v"(soff));
        char* xbase = (char*)(xb + (size_t)u.pm * BM * 1024 + (size_t)u.pn * BM);
        char* sbase = (char*)ss + (size_t)u.pm * BM * 64 + u.pn * 16;
#pragma unroll
        for (int ai = 0; ai < 2; ++ai)
#pragma unroll
            for (int m = 0; m < 4; ++m) { const int ro = ai * HALF + m * 16; float q = 0.f; u32x2 b[2][2];
#pragma unroll
                for (int bj = 0; bj < 2; ++bj)
#pragma unroll
                    for (int n = 0; n < 2; ++n) b[bj][n] = *(const u32x2*)(xbase + eoff + (ro * 1024 + bj * HALF + n * 16) * 2);
#pragma unroll
                for (int bj = 0; bj < 2; ++bj)
#pragma unroll
                    for (int n = 0; n < 2; ++n) { const u32x2 bw = b[bj][n];
                        const f32x4 bb = (f32x4){__uint_as_float(bw.x << 16), __uint_as_float(bw.x & 0xffff0000u), __uint_as_float(bw.y << 16), __uint_as_float(bw.y & 0xffff0000u)};
                        const f32x4 o = bb + acc[ai][bj][m][n];
                        u32x2 w; w.x = cvtpk(o[0], o[1]); w.y = cvtpk(o[2], o[3]); *(u32x2*)(xbase + eoff + (ro * 1024 + bj * HALF + n * 16) * 2) = w;
                        q += (o[0] * o[0] + o[1] * o[1]) + (o[2] * o[2] + o[3] * o[3]); }
                q += __shfl_xor(q, 16); q += __shfl_xor(q, 32);
                if (fq == 0) *(float*)(sbase + soff + ro * 64) = q; }
    }
};
template <class Epi, class Sched, bool ALIGN_EPI = false, bool SP2 = false>
__device__ __forceinline__ void gemm_phase(PG8_LAS unsigned char* lds, const Gemm g, const Sched& S, const Epi& E) {
    int tid_ = threadIdx.x; asm volatile("" : "+v"(tid_));
    const int tid = tid_, wid = __builtin_amdgcn_readfirstlane(tid >> 6), lane = tid & 63, wr = wid >> 2, wc = wid & 3, fr = lane & 15, fq = lane >> 4;
    const int K = g.K, nt = K / BK;
    unsigned voffA[2], voffB[2];
#pragma unroll
    for (int i = 0; i < 2; ++i) { int R, C; stage_rc(tid * 16 + i * 8192, R, C); const int Rb = Epi::PERM ? ((R & ~31) + perm32(R & 31)) : R;
        voffA[i] = (unsigned)(R * K + C) * 2u; voffB[i] = (unsigned)(Rb * K + C) * 2u; }
    const size_t kstep = (size_t)(BK * 2);
    const size_t hstep = (size_t)HALF * K * 2;
    const size_t tstep = 2 * hstep;
    const unsigned ldsw = (unsigned)wid * 1024u;
    const int aoff = lds_byte(wr * 64 + fr, fq * 8), boff = lds_byte(wc * 32 + fr, fq * 8);
#define PG8_SA(b, h) (((b) * 2 + (h)) * HTB)
#define PG8_SB(b, h) ((4 + (b) * 2 + (h)) * HTB)
#define PG8_STAGE(bufoff, gbase, voff) do { _Pragma("unroll") for (int _i = 0; _i < 2; ++_i) \
        __builtin_amdgcn_global_load_lds((const unsigned*)((const char*)(gbase) + (voff)[_i]), (PG8_LAS unsigned*)(lds + (bufoff) + ldsw + _i * 8192), 16, 0, 0); } while (0)
#define PG8_LDA(dst, b, h) do { _Pragma("unroll") for (int m = 0; m < 4; ++m) _Pragma("unroll") for (int k = 0; k < 2; ++k) dst[m][k] = *(const PG8_LAS bf16x8*)(lds + PG8_SA(b, h) + aoff + m * 2048 + k * 1024); } while (0)
#define PG8_LDB(dst, b, h) do { _Pragma("unroll") for (int n = 0; n < 2; ++n) _Pragma("unroll") for (int k = 0; k < 2; ++k) dst[n][k] = *(const PG8_LAS bf16x8*)(lds + PG8_SB(b, h) + boff + n * 2048 + k * 1024); } while (0)
#define PG8_MMA(ai, bj, At, Bt) do { __builtin_amdgcn_s_setprio(1); _Pragma("unroll") for (int m = 0; m < 4; ++m) _Pragma("unroll") for (int n = 0; n < 2; ++n) _Pragma("unroll") for (int k = 0; k < 2; ++k) \
        acc[ai][bj][m][n] = __builtin_amdgcn_mfma_f32_16x16x32_bf16(Bt[n][k], At[m][k], acc[ai][bj][m][n], 0, 0, 0); __builtin_amdgcn_s_setprio(0); } while (0)
#define PG8_WAIT_V(n) asm volatile("s_waitcnt vmcnt(" #n ")" ::: "memory")
#define PG8_WAIT_L(n) asm volatile("s_waitcnt lgkmcnt(" #n ")" ::: "memory")
#define PG8_BAR __builtin_amdgcn_s_barrier()
#define PG8_SCHED __builtin_amdgcn_sched_barrier(0)
    Unit cur, nxt; int ui = 0;
    if (!S.next(0, cur)) return;
    f32x4 acc[2][2][4][2];
#pragma unroll
    for (int a = 0; a < 2; ++a)
#pragma unroll
        for (int b = 0; b < 2; ++b)
#pragma unroll
            for (int m = 0; m < 4; ++m)
#pragma unroll
                for (int n = 0; n < 2; ++n) acc[a][b][m][n] = (f32x4){0.f, 0.f, 0.f, 0.f};
    bf16x8 At[4][2], B0[2][2], B1[2][2];
    const char* cA = (const char*)g.A + (size_t)cur.pm * tstep; const char* cB = (const char*)g.Bt + (size_t)cur.pn * tstep;
    S.a_ready(cur);
    if constexpr (SP2) {
        PG8_STAGE(PG8_SB(0, 0), cB, voffB); PG8_STAGE(PG8_SB(0, 1), cB + hstep, voffB); PG8_STAGE(PG8_SA(0, 0), cA, voffA); PG8_STAGE(PG8_SA(0, 1), cA + hstep, voffA);
        if (wr == 1) PG8_BAR;
        PG8_WAIT_V(2); PG8_BAR;
        PG8_STAGE(PG8_SB(1, 0), cB + kstep, voffB); PG8_STAGE(PG8_SA(1, 0), cA + kstep, voffA); PG8_STAGE(PG8_SB(1, 1), cB + hstep + kstep, voffB);
        PG8_WAIT_V(6); PG8_BAR;
    } else {
        PG8_STAGE(PG8_SB(0, 0), cB, voffB); PG8_STAGE(PG8_SA(0, 0), cA, voffA); PG8_STAGE(PG8_SB(0, 1), cB + hstep, voffB); PG8_STAGE(PG8_SA(0, 1), cA + hstep, voffA);
        if (wr == 1) PG8_BAR;
        PG8_WAIT_V(4); PG8_BAR;
        PG8_STAGE(PG8_SB(1, 0), cB + kstep, voffB); PG8_STAGE(PG8_SA(1, 0), cA + kstep, voffA); PG8_STAGE(PG8_SB(1, 1), cB + hstep + kstep, voffB);
        PG8_WAIT_V(6); PG8_BAR;
    }
    for (;;) {
        const bool has_next = S.next(ui + 1, nxt);
        const char* nA = has_next ? (const char*)g.A + (size_t)nxt.pm * tstep : cA; const char* nB = has_next ? (const char*)g.Bt + (size_t)nxt.pn * tstep : cB;
        for (int t = 0; t < nt; t += 2) {
            const bool last = (t == nt - 2);
            const char* a1 = cA + (size_t)(t + 1) * kstep;
            const char* a2 = last ? nA : cA + (size_t)(t + 2) * kstep; const char* b2 = last ? nB : cB + (size_t)(t + 2) * kstep;
            const char* a3 = a2 + kstep; const char* b3 = b2 + kstep;
            if (last && has_next) S.a_ready(nxt);
            if constexpr (SP2) {
            PG8_LDB(B0, 0, 0); PG8_LDB(B1, 0, 1); PG8_SCHED; PG8_LDA(At, 0, 0); PG8_STAGE(PG8_SA(1, 1), a1 + hstep, voffA);
            PG8_WAIT_V(8); PG8_WAIT_L(0); PG8_BAR; PG8_MMA(0, 0, At, B0); PG8_MMA(0, 1, At, B1); PG8_BAR; PG8_SCHED;
            PG8_LDA(At, 0, 1); PG8_STAGE(PG8_SB(0, 0), b2, voffB); PG8_STAGE(PG8_SB(0, 1), b2 + hstep, voffB); PG8_STAGE(PG8_SA(0, 0), a2, voffA);
            PG8_WAIT_V(8); PG8_WAIT_L(0); PG8_BAR; PG8_MMA(1, 0, At, B0); PG8_MMA(1, 1, At, B1); PG8_BAR; PG8_SCHED;
            PG8_LDB(B0, 1, 0); PG8_LDB(B1, 1, 1); PG8_SCHED; PG8_LDA(At, 1, 0); PG8_STAGE(PG8_SA(0, 1), a2 + hstep, voffA);
            PG8_WAIT_V(8); PG8_WAIT_L(0); PG8_BAR; PG8_MMA(0, 0, At, B0); PG8_MMA(0, 1, At, B1); PG8_BAR; PG8_SCHED;
            PG8_LDA(At, 1, 1); PG8_STAGE(PG8_SB(1, 0), b3, voffB); PG8_STAGE(PG8_SB(1, 1), b3 + hstep, voffB); PG8_STAGE(PG8_SA(1, 0), a3, voffA);
            PG8_WAIT_V(8); PG8_WAIT_L(0); PG8_BAR; PG8_MMA(1, 0, At, B0); PG8_MMA(1, 1, At, B1); PG8_BAR; PG8_SCHED;
            } else {
            PG8_LDB(B0, 0, 0); PG8_SCHED; PG8_LDA(At, 0, 0); PG8_STAGE(PG8_SA(1, 1), a1 + hstep, voffA);
            PG8_WAIT_L(8); PG8_BAR; PG8_WAIT_L(0); PG8_MMA(0, 0, At, B0); PG8_BAR; PG8_SCHED;
            PG8_LDB(B1, 0, 1); PG8_STAGE(PG8_SB(0, 0), b2, voffB);
            PG8_BAR; PG8_WAIT_L(0); PG8_MMA(0, 1, At, B1); PG8_BAR;
            PG8_LDA(At, 0, 1); PG8_STAGE(PG8_SA(0, 0), a2, voffA);
            PG8_BAR; PG8_WAIT_L(0); PG8_MMA(1, 0, At, B0); PG8_BAR; PG8_SCHED;
            PG8_STAGE(PG8_SB(0, 1), b2 + hstep, voffB);
            PG8_WAIT_V(6); PG8_BAR; PG8_MMA(1, 1, At, B1); PG8_BAR;
            PG8_LDB(B0, 1, 0); PG8_SCHED; PG8_LDA(At, 1, 0); PG8_STAGE(PG8_SA(0, 1), a2 + hstep, voffA);
            PG8_WAIT_L(8); PG8_BAR; PG8_WAIT_L(0); PG8_MMA(0, 0, At, B0); PG8_BAR; PG8_SCHED;
            PG8_LDB(B1, 1, 1); PG8_STAGE(PG8_SB(1, 0), b3, voffB);
            PG8_BAR; PG8_WAIT_L(0); PG8_MMA(0, 1, At, B1); PG8_BAR;
            PG8_LDA(At, 1, 1); PG8_STAGE(PG8_SA(1, 0), a3, voffA);
            PG8_BAR; PG8_WAIT_L(0); PG8_MMA(1, 0, At, B0); PG8_BAR; PG8_SCHED;
            PG8_STAGE(PG8_SB(1, 1), b3 + hstep, voffB);
            PG8_WAIT_V(6); PG8_BAR; PG8_MMA(1, 1, At, B1); PG8_BAR;
            }
        }
        if constexpr (ALIGN_EPI) { if (wr == 0) PG8_BAR; }
        if constexpr (!Epi::AFTER_DRAIN) { E(acc, cur, wr, wc, fr, fq); S.done(cur); }
        if (!has_next) break;
#pragma unroll
        for (int a = 0; a < 2; ++a)
#pragma unroll
            for (int b = 0; b < 2; ++b)
#pragma unroll
                for (int m = 0; m < 4; ++m)
#pragma unroll
                    for (int n = 0; n < 2; ++n) acc[a][b][m][n] = (f32x4){0.f, 0.f, 0.f, 0.f};
        cur = nxt; cA = nA; cB = nB; ++ui;
        if constexpr (ALIGN_EPI) { if (wr == 1) PG8_BAR; }
    }
    PG8_WAIT_V(0);
    if constexpr (!ALIGN_EPI) { if (wr == 0) PG8_BAR; }
    PG8_BAR;
    if constexpr (Epi::AFTER_DRAIN) { E.fused(acc, cur, wr, wc, fr, fq, lds, wid, lane); S.done(cur); }
#undef PG8_SA
#undef PG8_SB
#undef PG8_STAGE
#undef PG8_LDA
#undef PG8_LDB
#undef PG8_MMA
#undef PG8_WAIT_V
#undef PG8_WAIT_L
#undef PG8_BAR
#undef PG8_SCHED
}
}

constexpr int BATCH = 2, SEQ = 16384, DM = 1024, DEPTH = 4, M_TOK = BATCH * SEQ;
constexpr int PW = 2816;
constexpr int COL_K = 512, COL_V = 1024, COL_BG = 1536, COL_CG = 1792, COL_XH = 2048, COL_SU = 2304, COL_SV = 2560;
constexpr int DFF = 4096, NCHUNK = SEQ / 64;
constexpr float LOG2E = 1.4426950408889634f;
constexpr float QSCALE = 0.125f * LOG2E;
constexpr float EPS = 1e-6f;

#define LAS __attribute__((address_space(3)))
typedef unsigned short bf16;
typedef short bf16x8 __attribute__((ext_vector_type(8)));
typedef short s16x4 __attribute__((ext_vector_type(4)));
typedef float f32x4 __attribute__((ext_vector_type(4)));
typedef float f32x2 __attribute__((ext_vector_type(2)));
typedef unsigned u32x4 __attribute__((ext_vector_type(4)));
typedef unsigned u32x2 __attribute__((ext_vector_type(2)));
using pg8::cvtpk;

__device__ __forceinline__ float bf_lo(unsigned w) { return __uint_as_float(w << 16); }
__device__ __forceinline__ float bf_hi(unsigned w) { return __uint_as_float(w & 0xffff0000u); }
__device__ __forceinline__ s16x4 tr_read(const LAS unsigned char* p) { return __builtin_bit_cast(s16x4, __builtin_amdgcn_ds_read_tr16_b64_v4i16((LAS s16x4*)p)); }
__device__ __forceinline__ bf16x8 cat8(s16x4 lo, s16x4 hi) { return __builtin_shufflevector(lo, hi, 0, 1, 2, 3, 4, 5, 6, 7); }
#define MFMA16(a, b, c) __builtin_amdgcn_mfma_f32_16x16x32_bf16((a), (b), (c), 0, 0, 0)

constexpr int VP = 144;
constexpr int ATT_WAVE_LDS = 64 * VP + 1040;
__device__ __forceinline__ void att_load_k(bf16x8 (&k)[4][2], const bf16* kb, int fr, int fq) {
#pragma unroll
    for (int kt = 0; kt < 4; ++kt)
#pragma unroll
        for (int ks = 0; ks < 2; ++ks) k[kt][ks] = *(const bf16x8*)(kb + (size_t)(kt * 16 + fr) * PW + ks * 32 + fq * 8);
}
__device__ __forceinline__ void att_load_v(u32x4 (&v)[8], const bf16* vb, int lane) {
#pragma unroll
    for (int i = 0; i < 8; ++i) v[i] = *(const u32x4*)(vb + (size_t)(i * 8 + (lane >> 3)) * PW + (lane & 7) * 8);
}
__device__ __forceinline__ void att_store_v(LAS unsigned char* Vl, const u32x4 (&v)[8], int lane) {
#pragma unroll
    for (int i = 0; i < 8; ++i) *(LAS u32x4*)(Vl + (i * 8 + (lane >> 3)) * VP + (lane & 7) * 16) = v[i];
}
__device__ __forceinline__ void attn_item(const bf16* proj, bf16* mixed, const float* relb, int b, int c, int hg, LAS unsigned char* lds, int wid, int lane) {
    const int h = hg * 4 + (wid >> 1), qh = wid & 1, fr = lane & 15, fq = lane >> 4;
    LAS unsigned char* Vl = lds + wid * ATT_WAVE_LDS;
    LAS float* tb = (LAS float*)(Vl + 64 * VP);
    const size_t tokq = (size_t)b * SEQ + (size_t)c * 64 + qh * 32;
    bf16x8 qf[2][2];
#pragma unroll
    for (int qt = 0; qt < 2; ++qt)
#pragma unroll
        for (int ks = 0; ks < 2; ++ks) qf[qt][ks] = *(const bf16x8*)(proj + (tokq + qt * 16 + fr) * PW + h * 64 + ks * 32 + fq * 8);
    for (int i = lane; i < 257; i += 64) tb[i] = relb[h * 257 + i] * LOG2E;
    float mrun[2] = {-1e30f, -1e30f}, lrun[2] = {0.f, 0.f};
    f32x4 o[4][2];
#pragma unroll
    for (int dt = 0; dt < 4; ++dt)
#pragma unroll
        for (int qt = 0; qt < 2; ++qt) o[dt][qt] = (f32x4){0.f, 0.f, 0.f, 0.f};
    const int j0 = (c < 8) ? 8 - c : 0;
    const bf16* kbase = proj + ((size_t)b * SEQ) * PW + COL_K + h * 64;
    bf16x8 kf[4][2]; u32x4 vn[8];
    { const bf16* kb = kbase + (size_t)(c - 8 + j0) * 64 * PW; att_load_k(kf, kb, fr, fq); att_load_v(vn, kb + (COL_V - COL_K), lane); }
    att_store_v(Vl, vn, lane);
    asm volatile("" ::: "memory");
    const int iq0 = qh * 32 + fr;
    for (int j = j0; j <= 8; ++j) {
        bf16x8 kn[4][2];
        { const int jn = (j < 8) ? j + 1 : 8; const bf16* kb = kbase + (size_t)(c - 8 + jn) * 64 * PW; att_load_k(kn, kb, fr, fq); att_load_v(vn, kb + (COL_V - COL_K), lane); }
        f32x4 s[4][2];
#pragma unroll
        for (int kt = 0; kt < 4; ++kt)
#pragma unroll
            for (int qt = 0; qt < 2; ++qt) { f32x4 a = (f32x4){0.f, 0.f, 0.f, 0.f}; a = MFMA16(kf[kt][0], qf[qt][0], a); a = MFMA16(kf[kt][1], qf[qt][1], a); s[kt][qt] = a; }
        if (j <= 5) { const float bc = tb[256];
#pragma unroll
            for (int kt = 0; kt < 4; ++kt)
#pragma unroll
                for (int qt = 0; qt < 2; ++qt) s[kt][qt] = s[kt][qt] + bc;
        } else { const int cb = 512 - 64 * j;
#pragma unroll
            for (int kt = 0; kt < 4; ++kt)
#pragma unroll
                for (int qt = 0; qt < 2; ++qt)
#pragma unroll
                    for (int r = 0; r < 4; ++r) { int rel = (iq0 + qt * 16) - (kt * 16 + 4 * fq + r) + cb; rel = rel < -128 ? -128 : (rel > 128 ? 128 : rel); s[kt][qt][r] += tb[rel + 128]; }
        }
        bf16x8 pf[2][2];
#pragma unroll
        for (int qt = 0; qt < 2; ++qt) {
            float mx = s[0][qt][0];
#pragma unroll
            for (int kt = 0; kt < 4; ++kt)
#pragma unroll
                for (int r = 0; r < 4; ++r) mx = fmaxf(mx, s[kt][qt][r]);
            mx = fmaxf(mx, __shfl_xor(mx, 16)); mx = fmaxf(mx, __shfl_xor(mx, 32));
            const float mn = fmaxf(mrun[qt], mx), al = __builtin_amdgcn_exp2f(mrun[qt] - mn); mrun[qt] = mn;
            float ps = 0.f;
#pragma unroll
            for (int kt = 0; kt < 4; ++kt)
#pragma unroll
                for (int r = 0; r < 4; ++r) { const float p = __builtin_amdgcn_exp2f(s[kt][qt][r] - mn); s[kt][qt][r] = p; ps += p; }
            lrun[qt] = lrun[qt] * al + ps;
#pragma unroll
            for (int dt = 0; dt < 4; ++dt) o[dt][qt] = o[dt][qt] * al;
#pragma unroll
            for (int s2 = 0; s2 < 2; ++s2) { u32x4 w; w.x = cvtpk(s[2 * s2][qt][0], s[2 * s2][qt][1]); w.y = cvtpk(s[2 * s2][qt][2], s[2 * s2][qt][3]);
                w.z = cvtpk(s[2 * s2 + 1][qt][0], s[2 * s2 + 1][qt][1]); w.w = cvtpk(s[2 * s2 + 1][qt][2], s[2 * s2 + 1][qt][3]); pf[qt][s2] = __builtin_bit_cast(bf16x8, w); }
        }
        const LAS unsigned char* vrd = Vl + (4 * fq + (fr >> 2)) * VP + (lane & 3) * 8;
#pragma unroll
        for (int s2 = 0; s2 < 2; ++s2)
#pragma unroll
            for (int dt = 0; dt < 4; ++dt) {
                const s16x4 lo = tr_read(vrd + (32 * s2) * VP + dt * 32), hi = tr_read(vrd + (32 * s2 + 16) * VP + dt * 32);
                const bf16x8 vf = cat8(lo, hi);
#pragma unroll
                for (int qt = 0; qt < 2; ++qt) o[dt][qt] = MFMA16(vf, pf[qt][s2], o[dt][qt]);
            }
        asm volatile("" ::: "memory");
        att_store_v(Vl, vn, lane);
        asm volatile("" ::: "memory");
#pragma unroll
        for (int kt = 0; kt < 4; ++kt)
#pragma unroll
            for (int ks = 0; ks < 2; ++ks) kf[kt][ks] = kn[kt][ks];
    }
#pragma unroll
    for (int qt = 0; qt < 2; ++qt) {
        float l = lrun[qt]; l += __shfl_xor(l, 16); l += __shfl_xor(l, 32);
        const float inv = 1.0f / l; float q = 0.f;
#pragma unroll
        for (int dt = 0; dt < 4; ++dt) { o[dt][qt] = o[dt][qt] * inv; const f32x4 v = o[dt][qt]; q += (v[0] * v[0] + v[1] * v[1]) + (v[2] * v[2] + v[3] * v[3]); }
        q += __shfl_xor(q, 16); q += __shfl_xor(q, 32);
        const float rs = __builtin_amdgcn_rsqf(q * (1.0f / 64.0f) + EPS);
        bf16* op = mixed + (tokq + qt * 16 + fr) * DM + h * 64 + 4 * fq;
#pragma unroll
        for (int dt = 0; dt < 4; ++dt) { const f32x4 v = o[dt][qt] * rs; u32x2 w; w.x = cvtpk(v[0], v[1]); w.y = cvtpk(v[2], v[3]); *(u32x2*)(op + dt * 16) = w; }
    }
}

__device__ __forceinline__ void unpack8(float (&f)[8], u32x4 w) { f[0] = bf_lo(w.x); f[1] = bf_hi(w.x); f[2] = bf_lo(w.y); f[3] = bf_hi(w.y); f[4] = bf_lo(w.z); f[5] = bf_hi(w.z); f[6] = bf_lo(w.w); f[7] = bf_hi(w.w); }
__device__ __forceinline__ void conv_item(const bf16* proj, bf16* mixed, const float* cw, int item, int tid) {
    const int oc = tid & 31, c0 = oc * 8;
    float w0[8], w1[8], w2[8];
#pragma unroll
    for (int i = 0; i < 8; ++i) { w0[i] = cw[c0 + i]; w1[i] = cw[256 + c0 + i]; w2[i] = cw[512 + c0 + i]; }
#pragma unroll 1
    for (int pass = 0; pass < 4; ++pass) {
        const int t = item * 64 + pass * 16 + (tid >> 5), ts = t & (SEQ - 1);
        const bf16* rp = proj + (size_t)t * PW + c0;
        float bg[8], z[8], y[8], a[8], x[8];
        unpack8(bg, *(const u32x4*)(rp + COL_BG));
        unpack8(a, *(const u32x4*)(rp + COL_CG)); unpack8(x, *(const u32x4*)(rp + COL_XH));
#pragma unroll
        for (int i = 0; i < 8; ++i) y[i] = w2[i] * (a[i] * x[i]);
        if (ts >= 1) { unpack8(a, *(const u32x4*)(rp - PW + COL_CG)); unpack8(x, *(const u32x4*)(rp - PW + COL_XH));
#pragma unroll
            for (int i = 0; i < 8; ++i) y[i] += w1[i] * (a[i] * x[i]); }
        if (ts >= 2) { unpack8(a, *(const u32x4*)(rp - 2 * PW + COL_CG)); unpack8(x, *(const u32x4*)(rp - 2 * PW + COL_XH));
#pragma unroll
            for (int i = 0; i < 8; ++i) y[i] += w0[i] * (a[i] * x[i]); }
        float q = 0.f;
#pragma unroll
        for (int i = 0; i < 8; ++i) { z[i] = bg[i] * y[i]; q += z[i] * z[i]; }
        q += __shfl_xor(q, 1); q += __shfl_xor(q, 2); q += __shfl_xor(q, 4);
        const float rs = __builtin_amdgcn_rsqf(q * (1.0f / 64.0f) + EPS);
        u32x4 w; w.x = cvtpk(z[0] * rs, z[1] * rs); w.y = cvtpk(z[2] * rs, z[3] * rs); w.z = cvtpk(z[4] * rs, z[5] * rs); w.w = cvtpk(z[6] * rs, z[7] * rs);
        *(u32x4*)(mixed + (size_t)t * DM + 512 + c0) = w;
    }
}

constexpr int GP = 544;
__device__ __forceinline__ void gate_item(const bf16* proj, bf16* mixed, const float* lng, const float* lnb, const bf16* wsb, const float* sgb, int blk, LAS unsigned char* lds, int tid, int wid, int lane) {
    const size_t tok0 = (size_t)blk * 128;
    { const int tk = tid >> 2, part = tid & 3;
        const bf16* rp = proj + (tok0 + tk) * PW + COL_SV + part * 64;
        float x[64];
#pragma unroll
        for (int i = 0; i < 8; ++i) { float f[8]; unpack8(f, *(const u32x4*)(rp + i * 8));
#pragma unroll
            for (int k = 0; k < 8; ++k) x[i * 8 + k] = f[k]; }
        float sm = 0.f;
#pragma unroll
        for (int i = 0; i < 64; ++i) sm += x[i];
        sm += __shfl_xor(sm, 1); sm += __shfl_xor(sm, 2);
        const float mu = sm * (1.0f / 256.0f); float q = 0.f;
#pragma unroll
        for (int i = 0; i < 64; ++i) { x[i] -= mu; q += x[i] * x[i]; }
        q += __shfl_xor(q, 1); q += __shfl_xor(q, 2);
        const float rs = __builtin_amdgcn_rsqf(q * (1.0f / 256.0f) + EPS);
        LAS unsigned char* wp = lds + tk * GP + part * 128;
#pragma unroll
        for (int i = 0; i < 8; ++i) { const f32x4 g0 = *(const f32x4*)(lng + part * 64 + i * 8), g1 = *(const f32x4*)(lng + part * 64 + i * 8 + 4), b0 = *(const f32x4*)(lnb + part * 64 + i * 8), b1 = *(const f32x4*)(lnb + part * 64 + i * 8 + 4);
            u32x4 w; w.x = cvtpk(x[i * 8 + 0] * rs * g0[0] + b0[0], x[i * 8 + 1] * rs * g0[1] + b0[1]); w.y = cvtpk(x[i * 8 + 2] * rs * g0[2] + b0[2], x[i * 8 + 3] * rs * g0[3] + b0[3]);
            w.z = cvtpk(x[i * 8 + 4] * rs * g1[0] + b1[0], x[i * 8 + 5] * rs * g1[1] + b1[1]); w.w = cvtpk(x[i * 8 + 6] * rs * g1[2] + b1[2], x[i * 8 + 7] * rs * g1[3] + b1[3]);
            *(LAS u32x4*)(wp + i * 16) = w; }
    }
    __syncthreads();
    {
        const int g = wid >> 1, th = wid & 1, fr = lane & 15, fq = lane >> 4;
        f32x4 acc[4][4];
#pragma unroll
        for (int ct = 0; ct < 4; ++ct)
#pragma unroll
            for (int tt = 0; tt < 4; ++tt) acc[ct][tt] = (f32x4){0.f, 0.f, 0.f, 0.f};
        const int nks = th ? 4 : 2;
        const LAS unsigned char* vrd = lds + (8 * fq + (fr >> 2)) * GP + g * 128 + (lane & 3) * 8;
        const bf16* wrow = wsb + ((size_t)g * 128 + th * 64 + fr) * 128 + 8 * fq;
#pragma unroll 1
        for (int ks = 0; ks < nks; ++ks) {
            bf16x8 vf[4];
#pragma unroll
            for (int ct = 0; ct < 4; ++ct) { const s16x4 lo = tr_read(vrd + (32 * ks) * GP + ct * 32), hi = tr_read(vrd + (32 * ks + 4) * GP + ct * 32); vf[ct] = cat8(lo, hi); }
#pragma unroll
            for (int tt = 0; tt < 4; ++tt) { const bf16x8 wf = *(const bf16x8*)(wrow + (size_t)(tt * 16) * 128 + ks * 32);
#pragma unroll
                for (int ct = 0; ct < 4; ++ct) acc[ct][tt] = MFMA16(vf[ct], wf, acc[ct][tt]); }
        }
#pragma unroll
        for (int tt = 0; tt < 4; ++tt) { const int t = th * 64 + tt * 16 + fr; const float bias = sgb[g * 128 + t];
            const bf16* up = proj + (tok0 + t) * PW + COL_SU + g * 64 + 4 * fq; float q = 0.f; f32x4 v[4];
#pragma unroll
            for (int ct = 0; ct < 4; ++ct) { const u32x2 uw = *(const u32x2*)(up + ct * 16); const f32x4 uu = (f32x4){bf_lo(uw.x), bf_hi(uw.x), bf_lo(uw.y), bf_hi(uw.y)};
                v[ct] = uu * (acc[ct][tt] + bias); q += (v[ct][0] * v[ct][0] + v[ct][1] * v[ct][1]) + (v[ct][2] * v[ct][2] + v[ct][3] * v[ct][3]); }
            q += __shfl_xor(q, 16); q += __shfl_xor(q, 32);
            const float rs = __builtin_amdgcn_rsqf(q * (1.0f / 64.0f) + EPS);
            bf16* op = mixed + (tok0 + t) * DM + 768 + g * 64 + 4 * fq;
#pragma unroll
            for (int ct = 0; ct < 4; ++ct) { const f32x4 r = v[ct] * rs; u32x2 w; w.x = cvtpk(r[0], r[1]); w.y = cvtpk(r[2], r[3]); *(u32x2*)(op + ct * 16) = w; }
        }
    }
    __syncthreads();
}

constexpr size_t MiB = 1u << 20;
constexpr size_t SZ_WIN = (size_t)PW * DM * 2, SZ_WOUT = (size_t)DM * DM * 2, SZ_WUP = (size_t)DFF * DM * 2, SZ_WDN = (size_t)DM * DFF * 2, SZ_WSG = (size_t)4 * 128 * 128 * 2;
constexpr size_t WS_WIN = 0;
constexpr size_t WS_WOUT = WS_WIN + DEPTH * SZ_WIN;
constexpr size_t WS_WUP = WS_WOUT + DEPTH * SZ_WOUT;
constexpr size_t WS_WDN = WS_WUP + DEPTH * SZ_WUP;
constexpr size_t WS_WSG = WS_WDN + DEPTH * SZ_WDN;
constexpr size_t WS_SS = WS_WSG + DEPTH * SZ_WSG;
constexpr size_t WS_XB = WS_SS + (size_t)M_TOK * 16 * 4;
constexpr size_t WS_PROJ = WS_XB + (size_t)M_TOK * DM * 2;
constexpr size_t WS_MIX = WS_PROJ + (size_t)M_TOK * PW * 2;
constexpr size_t WS_HDN = WS_PROJ;
constexpr size_t WS_CTL = WS_HDN + (size_t)M_TOK * DFF * 2, CTL_BYTES = 65536;
constexpr size_t WS_END = WS_CTL + CTL_BYTES;
static_assert(WS_MIX + (size_t)M_TOK * DM * 2 <= WS_CTL, "hdn covers proj + mixed");
static_assert(WS_WOUT % 256 == 0 && WS_WUP % 256 == 0 && WS_WDN % 256 == 0 && WS_WSG % 256 == 0 && WS_SS % 256 == 0 && WS_XB % 256 == 0 && WS_PROJ % 256 == 0 && WS_MIX % 256 == 0, "alignment");

constexpr int NWAVES = 8;
constexpr int LDS_BYTES = 132096;
static_assert(8 * ATT_WAVE_LDS <= 131072 && 128 * GP <= 131072, "LDS map");

#define XB_TMO      128
#define XB_XCNT(j)  (256  + 64 * (j))
#define XB_XSUB(j)  (1280 + 64 * (j))
#define XB_XGEN(j)  (2304 + 64 * (j))
#define XB_TOP      3328
#define XB_TOPGEN   3392
#define XCD_BAR_WORDS 3456
#define XB_SPIN_CAP (1u << 18)

__device__ __forceinline__ unsigned xb_ld(unsigned* p)              { return __hip_atomic_load(p, __ATOMIC_RELAXED, __HIP_MEMORY_SCOPE_AGENT); }
__device__ __forceinline__ unsigned xb_add(unsigned* p, unsigned v) { return __hip_atomic_fetch_add(p, v, __ATOMIC_RELAXED, __HIP_MEMORY_SCOPE_AGENT); }
__device__ __forceinline__ unsigned xb_xcc_id() { return (unsigned)__builtin_amdgcn_s_getreg((3 << 11) | 20) & 0xFu; }
#define XB_SPIN(cond, bar) do { unsigned _sp = 0; while (cond) { __builtin_amdgcn_s_sleep(1); \
    if ((++_sp & 255u) == 0u) { if (xb_ld(&(bar)[XB_TMO])) break; if (_sp > XB_SPIN_CAP) { atomicAdd(&(bar)[XB_TMO], 1u); break; } } } } while (0)

struct XcdBarrier {
    unsigned* bar; unsigned x;
    volatile LAS unsigned* st;
};

__device__ __forceinline__ XcdBarrier xcd_barrier_post(unsigned* bar, volatile LAS unsigned* st) {
    XcdBarrier b; b.bar = bar; b.x = xb_xcc_id(); b.st = st;
    if (threadIdx.x == 0) (void)xb_add(&bar[XB_XCNT(b.x)], 1u);
    return b;
}
__device__ __forceinline__ void xcd_barrier_complete(unsigned* bar, unsigned x, unsigned& nloc, unsigned& nx) {
    const unsigned G = gridDim.x * gridDim.y * gridDim.z;
    unsigned sum, cnt, mine, sp = 0u;
    for (;;) {
        sum = 0u; cnt = 0u; mine = 0u;
#pragma unroll
        for (unsigned j = 0; j < 16; ++j) { const unsigned c = xb_ld(&bar[XB_XCNT(j)]); sum += c; cnt += (c > 0u) ? 1u : 0u; mine = (j == x) ? c : mine; }
        if (sum == G) break;
        __builtin_amdgcn_s_sleep(1);
        if ((++sp & 255u) == 0u) { if (xb_ld(&bar[XB_TMO])) break; if (sp > XB_SPIN_CAP) { atomicAdd(&bar[XB_TMO], 1u); break; } }
    }
    nloc = mine > 0u ? mine : 1u; nx = cnt > 0u ? cnt : 1u;
}

__device__ __forceinline__ void xcd_barrier(const XcdBarrier& b) {
    asm volatile("s_waitcnt vmcnt(0)" ::: "memory");
    __syncthreads();
    if (threadIdx.x == 0) {
        unsigned* bar = b.bar;
        __builtin_amdgcn_s_waitcnt(0);
        unsigned nloc = b.st[0], nx = b.st[1];
        if (nloc == 0u) { xcd_barrier_complete(bar, b.x, nloc, nx); b.st[0] = nloc; b.st[1] = nx; }
        const unsigned old = xb_add(&bar[XB_XSUB(b.x)], 1u);
        const unsigned gen = old / nloc;
        if (old + 1u == (gen + 1u) * nloc) {
            __builtin_amdgcn_fence(__ATOMIC_RELEASE, "agent");
            asm volatile("s_waitcnt vmcnt(0)" ::: "memory");
            const unsigned og = xb_add(&bar[XB_TOP], 1u);
            const unsigned tg = og / nx;
            if (og + 1u == (tg + 1u) * nx) xb_add(&bar[XB_TOPGEN], 1u);
            else XB_SPIN(xb_ld(&bar[XB_TOPGEN]) == tg, bar);
            __builtin_amdgcn_fence(__ATOMIC_ACQUIRE, "agent");
            xb_add(&bar[XB_XGEN(b.x)], 1u);
            asm volatile("s_waitcnt vmcnt(0)" ::: "memory");
        } else {
            XB_SPIN(xb_ld(&bar[XB_XGEN(b.x)]) == gen, bar);
            __builtin_amdgcn_fence(__ATOMIC_ACQUIRE, "agent");
            asm volatile("s_waitcnt vmcnt(0)" ::: "memory");
        }
    }
    __syncthreads();
}

__device__ __forceinline__ unsigned f2bf(float f) { unsigned u = __builtin_bit_cast(unsigned, f); return (u + 0x7fffu + ((u >> 16) & 1u)) >> 16; }
__device__ __forceinline__ unsigned pk2(float lo, float hi) { return f2bf(lo) | (f2bf(hi) << 16); }
__device__ __forceinline__ float wave_sum(float v) {
#pragma unroll
    for (int o = 1; o < 64; o <<= 1) v += __shfl_xor(v, o);
    return v;
}
__device__ __forceinline__ void p0_transpose_item(const float* W, const float* gain, int K, int N, bf16* WT, LAS float* scr, int item, int lane) {
    const int nblk = N / 32, kb = item / nblk, nb = item % nblk, k0 = 64 * kb, n0 = 32 * nb;
#pragma unroll 8
    for (int i = 0; i < 32; ++i) { const int kk = 2 * i + (lane >> 5); const float gsc = gain ? gain[k0 + kk] : 1.0f; scr[kk * 33 + (lane & 31)] = W[(size_t)(k0 + kk) * N + n0 + (lane & 31)] * gsc; }
    asm volatile("s_waitcnt lgkmcnt(0)" ::: "memory");
    const int c = lane & 7;
#pragma unroll
    for (int j = 0; j < 4; ++j) { const int n = (lane >> 3) + 8 * j; const LAS float* s = scr + (8 * c) * 33 + n;
        u32x4 o; o.x = pk2(s[0 * 33], s[1 * 33]); o.y = pk2(s[2 * 33], s[3 * 33]); o.z = pk2(s[4 * 33], s[5 * 33]); o.w = pk2(s[6 * 33], s[7 * 33]);
        *(u32x4*)(WT + (size_t)(n0 + n) * K + k0 + 8 * c) = o; }
    asm volatile("s_waitcnt lgkmcnt(0)" ::: "memory");
}

struct Args { const float* in[15]; float* out; unsigned char* ws; };

__global__ void __launch_bounds__(NWAVES * 64, 2) trunk_fwd(Args args) {
    extern __shared__ __attribute__((aligned(16))) unsigned char lds_raw[];
    cg::grid_group grid = cg::this_grid();
    LAS unsigned char* lds = (LAS unsigned char*)lds_raw;
    const int G = gridDim.x, bx = blockIdx.x;
    const int vcu = (G % 8 == 0) ? (bx % 8) * (G / 8) + bx / 8 : bx;
    unsigned char* ws = args.ws;
    if (threadIdx.x < 64) ((LAS unsigned*)(lds + 131072))[threadIdx.x] = 0u;
    __syncthreads();
    const XcdBarrier bar = xcd_barrier_post((unsigned*)(ws + WS_CTL), (volatile LAS unsigned*)(lds + 131072));
    const float* x_in = args.in[0];
    float* X = args.out;
    bf16* XB = (bf16*)(ws + WS_XB); float* SS = (float*)(ws + WS_SS);
    bf16* PROJ = (bf16*)(ws + WS_PROJ); bf16* MIXB = (bf16*)(ws + WS_MIX); bf16* HDN = (bf16*)(ws + WS_HDN);

    {
        int tid = threadIdx.x; asm volatile("" : "+v"(tid)); const int lane = tid & 63, wid = __builtin_amdgcn_readfirstlane(tid >> 6);
        LAS float* scr = (LAS float*)(lds + wid * 16384);
        const int gw = vcu * NWAVES + wid, NGW = G * NWAVES;
        constexpr int I_IN = (DM / 64) * (PW / 32), I_OUT = (DM / 64) * (DM / 32), I_UP = (DM / 64) * (DFF / 32), I_DN = (DFF / 64) * (DM / 32), I_L = I_IN + I_OUT + I_UP + I_DN;
        for (int it = gw; it < DEPTH * I_L; it += NGW) {
            const int l = it / I_L; int r = it % I_L;
            if (r < I_IN) { p0_transpose_item(args.in[2] + (size_t)l * DM * PW, args.in[1] + l * DM, DM, PW, (bf16*)(ws + WS_WIN + l * SZ_WIN), scr, r, lane); continue; } r -= I_IN;
            if (r < I_OUT) { p0_transpose_item(args.in[10] + (size_t)l * DM * DM, args.in[9] + l * DM, DM, DM, (bf16*)(ws + WS_WOUT + l * SZ_WOUT), scr, r, lane); continue; } r -= I_OUT;
            if (r < I_UP) { p0_transpose_item(args.in[12] + (size_t)l * DM * DFF, args.in[11] + l * DM, DM, DFF, (bf16*)(ws + WS_WUP + l * SZ_WUP), scr, r, lane); continue; } r -= I_UP;
            p0_transpose_item(args.in[13] + (size_t)l * DFF * DM, nullptr, DFF, DM, (bf16*)(ws + WS_WDN + l * SZ_WDN), scr, r, lane);
        }
        { const float* sw = args.in[7]; bf16* wsg = (bf16*)(ws + WS_WSG);
            for (int i = bx * 512 + tid; i < DEPTH * 4 * 128 * 128 / 2; i += G * 512) { const int e = 2 * i, t = (e >> 7) & 127, s = e & 127; const f32x2 v = *(const f32x2*)(sw + e);
                ((unsigned*)wsg)[i] = pk2(s <= t ? v.x : 0.f, (s + 1) <= t ? v.y : 0.f); } }
        for (int m = gw; m < M_TOK; m += NGW) {
            const f32x4* xr = (const f32x4*)(x_in + (size_t)m * DM) + lane; unsigned long long* o8 = (unsigned long long*)(XB + (size_t)m * DM) + lane; float q = 0.f;
#pragma unroll
            for (int j = 0; j < 4; ++j) { const f32x4 v = xr[64 * j]; q += (v.x * v.x + v.y * v.y) + (v.z * v.z + v.w * v.w); o8[64 * j] = (unsigned long long)pk2(v.x, v.y) | ((unsigned long long)pk2(v.z, v.w) << 32); }
            q = wave_sum(q);
            if (lane < 16) SS[(size_t)m * 16 + lane] = (lane == 0) ? q : 0.f;
        }
    }
    grid.sync();

#pragma unroll 1
    for (int l = 0; l < DEPTH; ++l) {
        {
            pg8::Gemm g{XB, (const bf16*)(ws + WS_WIN + l * SZ_WIN), M_TOK, PW, DM}; pg8::StaticOrder S; S.init(M_TOK, PW, G, bx);
            pg8::EpiAct<0, PW> E{PROJ, SS, QSCALE};
            pg8::gemm_phase<pg8::EpiAct<0, PW>, pg8::StaticOrder, true, true>(lds, g, S, E);
        }
        xcd_barrier(bar);
#ifndef REP_P2
#define REP_P2 1
#endif
#pragma unroll 1
        for (int rep = 0; rep < REP_P2; ++rep) {
            int tid = threadIdx.x; asm volatile("" : "+v"(tid));
            const int lane = tid & 63, wid = __builtin_amdgcn_readfirstlane(tid >> 6);
            const float* relb = args.in[3] + (size_t)l * 8 * 257;
            for (int u = vcu; u < BATCH * 2 * NCHUNK; u += G) { const int c = u % NCHUNK, bh = u / NCHUNK; attn_item(PROJ, MIXB, relb, bh >> 1, c, bh & 1, lds, wid, lane); }
            for (int u = bx; u < M_TOK / 64; u += G) conv_item(PROJ, MIXB, args.in[4] + (size_t)l * 3 * 256, u, tid);
            __syncthreads();
            for (int u = bx; u < M_TOK / 128; u += G)
                gate_item(PROJ, MIXB, args.in[5] + l * 256, args.in[6] + l * 256, (const bf16*)(ws + WS_WSG + l * SZ_WSG), args.in[8] + l * 512, u, lds, tid, wid, lane);
        }
        xcd_barrier(bar);
        {
            pg8::Gemm g{MIXB, (const bf16*)(ws + WS_WOUT + l * SZ_WOUT), M_TOK, DM, DM}; pg8::StaticOrder S; S.init(M_TOK, DM, G, bx);
            pg8::EpiRes E{XB, SS};
            pg8::gemm_phase<pg8::EpiRes, pg8::StaticOrder, true, true>(lds, g, S, E);
        }
        xcd_barrier(bar);
        {
            pg8::Gemm g{XB, (const bf16*)(ws + WS_WUP + l * SZ_WUP), M_TOK, DFF, DM}; pg8::StaticOrder S; S.init(M_TOK, DFF, G, bx);
            pg8::EpiAct<1, DFF> E{HDN, SS, 1.0f};
            pg8::gemm_phase<pg8::EpiAct<1, DFF>, pg8::StaticOrder, true, true>(lds, g, S, E);
        }
        xcd_barrier(bar);
        {
            pg8::Gemm g{HDN, (const bf16*)(ws + WS_WDN + l * SZ_WDN), M_TOK, DM, DFF}; pg8::StaticOrder S; S.init(M_TOK, DM, G, bx);
            pg8::EpiRes E{XB, SS};
            pg8::gemm_phase<pg8::EpiRes, pg8::StaticOrder, true, true>(lds, g, S, E);
        }
        xcd_barrier(bar);
    }
    {
        int tidf = threadIdx.x; asm volatile("" : "+v"(tidf)); const int lane = tidf & 63, wid = __builtin_amdgcn_readfirstlane(tidf >> 6);
        const int gw = vcu * NWAVES + wid, NGW = G * NWAVES; const f32x4* gp = (const f32x4*)args.in[14] + lane;
        for (int m = gw; m < M_TOK; m += NGW) {
            f32x4* xr = (f32x4*)(X + (size_t)m * DM) + lane; const u32x2* br = (const u32x2*)(XB + (size_t)m * DM) + lane; f32x4 v[4]; float q = 0.f;
#pragma unroll
            for (int j = 0; j < 4; ++j) { const u32x2 w = br[64 * j]; v[j] = (f32x4){bf_lo(w.x), bf_hi(w.x), bf_lo(w.y), bf_hi(w.y)}; q += (v[j].x * v[j].x + v[j].y * v[j].y) + (v[j].z * v[j].z + v[j].w * v[j].w); }
            const float rs = 1.0f / sqrtf(wave_sum(q) * (1.0f / DM) + EPS);
#pragma unroll
            for (int j = 0; j < 4; ++j) xr[64 * j] = v[j] * rs * gp[64 * j];
        }
    }
}

extern "C" void kernel_launch(void* const* d_in, const int* in_sizes, int n_in, void* d_out, int out_size, void* d_ws, size_t ws_size, hipStream_t stream) {
    static int grid = 0;
    if (grid == 0) {
        if (n_in != 15 || in_sizes[0] != M_TOK * DM || out_size != M_TOK * DM || ws_size < WS_END) { fprintf(stderr, "kernel_launch: unexpected shapes (n_in %d, in0 %d, out %d, ws %zu < %zu); nothing launched\n", n_in, n_in > 0 ? in_sizes[0] : -1, out_size, ws_size, (size_t)WS_END); grid = -1; return; }
        int dev = 0, cus = 0, per_cu = 0;
        if (hipGetDevice(&dev) != hipSuccess || hipDeviceGetAttribute(&cus, hipDeviceAttributeMultiprocessorCount, dev) != hipSuccess) { grid = -1; return; }
        if (hipFuncSetAttribute((const void*)trunk_fwd, hipFuncAttributeMaxDynamicSharedMemorySize, LDS_BYTES) != hipSuccess) { fprintf(stderr, "kernel_launch: hipFuncSetAttribute failed\n"); grid = -1; return; }
        if (hipOccupancyMaxActiveBlocksPerMultiprocessor(&per_cu, (const void*)trunk_fwd, NWAVES * 64, LDS_BYTES) != hipSuccess || per_cu < 1) { fprintf(stderr, "kernel_launch: occupancy query says %d blocks per CU\n", per_cu); per_cu = 1; }
        (void)hipGetLastError();
        grid = cus * per_cu;
    }
    if (grid < 0) return;
    if (hipMemsetAsync((char*)d_ws + WS_CTL, 0, CTL_BYTES, stream) != hipSuccess) { fprintf(stderr, "kernel_launch: memset failed\n"); return; }
    Args a{};
    for (int i = 0; i < 15; ++i) a.in[i] = (const float*)d_in[i];
    a.out = (float*)d_out; a.ws = (unsigned char*)d_ws;
    void* kargs[] = {&a};
    hipError_t e = hipLaunchCooperativeKernel((const void*)trunk_fwd, dim3(grid), dim3(NWAVES * 64), kargs, LDS_BYTES, stream);
    if (e != hipSuccess) fprintf(stderr, "kernel_launch: cooperative launch failed: %s (grid %d)\n", hipGetErrorString(e), grid);
}
```

```cpp
#include <hip/hip_runtime.h>
#include <hip/hip_cooperative_groups.h>
#include <cstdio>
#include <cstdint>
namespace cg = cooperative_groups;
namespace pg8 {
#define PG8_LAS __attribute__((address_space(3)))
typedef unsigned short bf16_t;
typedef short bf16x8 __attribute__((ext_vector_type(8)));
typedef float f32x4 __attribute__((ext_vector_type(4)));
typedef unsigned u32x4 __attribute__((ext_vector_type(4)));
constexpr int BM = 256, BK = 64, HALF = 128, HTB = HALF * BK * 2  , STAGE_BYTES = 8 * HTB, NXCD = 8, WGM = 8;

__host__ __device__ __forceinline__ int lds_byte(int r, int c) { const int st = (r >> 4) * 2 + (c >> 5), rr = r & 15, cc = c & 31, ob = rr * 64 + cc * 2; return st * 1024 + (ob ^ (((ob >> 9) & 1) << 5)); }
__host__ __device__ __forceinline__ void stage_rc(int b, int& R, int& C) { const int st = b / 1024, sb = b % 1024, swz = sb ^ (((sb >> 9) & 1) << 5); R = (st >> 1) * 16 + swz / 64; C = (st & 1) * 32 + (swz % 64) / 2; }
__host__ __device__ __forceinline__ int perm32(int rho) { const int n = rho >> 4, i = rho & 15; return 8 * (i >> 2) + 4 * n + (i & 3); }

struct Unit { int pm, pn; };
struct Gemm { const bf16_t* A; const bf16_t* Bt; int M, N, K; };

struct StaticOrder {
    int nM, nN, nwg, G, c;
    __host__ __device__ void init(int M, int N, int G_, int c_) { nM = M / BM; nN = N / BM; nwg = nM * nN; G = G_; c = c_; }
    __host__ __device__ bool next(int i, Unit& u) const {
        const long L = (long)i * G + c; if (L >= nwg) return false;
        int wgid = (int)L; { const int q = nwg / NXCD, r = nwg % NXCD, xcd = wgid % NXCD, off = wgid / NXCD; wgid = (xcd < r ? xcd * (q + 1) : r * (q + 1) + (xcd - r) * q) + off; }
        const int nig = WGM * nN, gid = wgid / nig, fm = gid * WGM, gsz = (nM - fm) < WGM ? (nM - fm) : WGM;
        u.pm = fm + ((wgid % nig) % gsz); u.pn = (wgid % nig) / gsz; return true;
    }
    __device__ __forceinline__ void a_ready(const Unit&) const {}
    __device__ __forceinline__ void done(const Unit&) const {}
};

__device__ __forceinline__ unsigned cvt_pk_bf16(float lo, float hi) { unsigned r; asm volatile("v_cvt_pk_bf16_f32 %0, %1, %2" : "=v"(r) : "v"(lo), "v"(hi)); return r; }
typedef float f32x2 __attribute__((ext_vector_type(2)));
__device__ __forceinline__ f32x2 gelu_pk(f32x2 v) {
    const f32x2 av = __builtin_elementwise_abs(v), d = av * 0.2316418882f + 1.0f;
    f32x2 t; t.x = __builtin_amdgcn_rcpf(d.x); t.y = __builtin_amdgcn_rcpf(d.y);
    f32x2 q = t * 0.5307027145f + (-0.7265760135f); q = q * t + 0.7107068705f; q = q * t + (-0.142248368f); q = q * t + 0.127414796f; q = q * t;
    const f32x2 s = (v * v) * (-0.72134752044f);
    f32x2 e; e.x = __builtin_amdgcn_exp2f(s.x); e.y = __builtin_amdgcn_exp2f(s.y);
    const f32x2 m = v * (q * e), r = v - m;
    f32x2 o; o.x = v.x < 0.f ? m.x : r.x; o.y = v.y < 0.f ? m.y : r.y; return o;
}


typedef unsigned u32x2 __attribute__((ext_vector_type(2)));
typedef __bf16 bf16x2_t __attribute__((ext_vector_type(2)));
__device__ __forceinline__ unsigned cvtpk(float lo, float hi) { f32x2 v = {lo, hi}; bf16x2_t b = __builtin_convertvector(v, bf16x2_t); return __builtin_bit_cast(unsigned, b); }
constexpr float RMS_EPS = 1e-6f;
__device__ __forceinline__ float row_rstd(const char* rec) {
    const f32x4* p = (const f32x4*)rec;
    const f32x4 a = p[0], b = p[1], c = p[2], d = p[3];
    const f32x4 s = (a + b) + (c + d);
    const float t = (s[0] + s[1]) + (s[2] + s[3]);
    return __builtin_amdgcn_rsqf(t * (1.0f / 1024.0f) + RMS_EPS);
}
template <int MODE, int LDC> struct EpiAct {
    static constexpr bool PERM = true, AFTER_DRAIN = false;
    bf16_t* O; const float* ss; float qscale;
    __device__ __forceinline__ void operator()(const f32x4 (&acc)[2][2][4][2], const Unit& u, int wr, int wc, int fr, int fq) const {
        const int rl = wr * 64 + fr;
        unsigned ooff = (unsigned)(rl * LDC + wc * 32 + 8 * fq) * 2u, soff = (unsigned)rl * 64u;
        asm volatile("" : "+v"(ooff), "+v"(soff));
        char* obase = (char*)O + ((size_t)u.pm * BM * LDC + (size_t)u.pn * BM) * 2;
        const char* sbase = (const char*)ss + (size_t)u.pm * BM * 64;
        const float sc = (MODE == 0 && u.pn < 2) ? qscale : 1.0f; const bool act = (MODE == 0 && u.pn >= 9);
#pragma unroll
        for (int ai = 0; ai < 2; ++ai)
#pragma unroll
            for (int m = 0; m < 4; ++m) { const int ro = ai * HALF + m * 16; const float rs = row_rstd(sbase + soff + ro * 64) * sc; char* rowp = obase + ooff + (size_t)ro * LDC * 2;
#pragma unroll
                for (int bj = 0; bj < 2; ++bj) { f32x4 v0 = acc[ai][bj][m][0] * rs, v1 = acc[ai][bj][m][1] * rs;
                    if (MODE == 0) { if (act) { f32x2 a = gelu_pk((f32x2){v0[0], v0[1]}), b = gelu_pk((f32x2){v0[2], v0[3]}), c = gelu_pk((f32x2){v1[0], v1[1]}), d = gelu_pk((f32x2){v1[2], v1[3]});
                        v0 = (f32x4){a.x, a.y, b.x, b.y}; v1 = (f32x4){c.x, c.y, d.x, d.y}; } }
                    else { v0 = __builtin_elementwise_max(v0, (f32x4){0.f, 0.f, 0.f, 0.f}); v1 = __builtin_elementwise_max(v1, (f32x4){0.f, 0.f, 0.f, 0.f}); v0 = v0 * v0; v1 = v1 * v1; }
                    u32x4 w; w.x = cvtpk(v0[0], v0[1]); w.y = cvtpk(v0[2], v0[3]); w.z = cvtpk(v1[0], v1[1]); w.w = cvtpk(v1[2], v1[3]);
                    *(u32x4*)(rowp + bj * HALF * 2) = w; } }
    }
};
struct EpiRes {
    static constexpr bool PERM = false, AFTER_DRAIN = false;
    bf16_t* xb; float* ss;
    __device__ __forceinline__ void operator()(const f32x4 (&acc)[2][2][4][2], const Unit& u, int wr, int wc, int fr, int fq) const {
        const int rl = wr * 64 + fr;
        unsigned eoff = (unsigned)(rl * 1024 + wc * 32 + 4 * fq) * 2u, soff = (unsigned)(rl * 16 + wc) * 4u;
        asm volatile("" : "+v"(eoff), "+v"(soff));
        char* xbase = (char*)(xb + (size_t)u.pm * BM * 1024 + (size_t)u.pn * BM);
        char* sbase = (char*)ss + (size_t)u.pm * BM * 64 + u.pn * 16;
#pragma unroll
        for (int ai = 0; ai < 2; ++ai)
#pragma unroll
            for (int m = 0; m < 4; ++m) { const int ro = ai * HALF + m * 16; float q = 0.f; u32x2 b[2][2];
#pragma unroll
                for (int bj = 0; bj < 2; ++bj)
#pragma unroll
                    for (int n = 0; n < 2; ++n) b[bj][n] = *(const u32x2*)(xbase + eoff + (ro * 1024 + bj * HALF + n * 16) * 2);
#pragma unroll
                for (int bj = 0; bj < 2; ++bj)
#pragma unroll
                    for (int n = 0; n < 2; ++n) { const u32x2 bw = b[bj][n];
                        const f32x4 bb = (f32x4){__uint_as_float(bw.x << 16), __uint_as_float(bw.x & 0xffff0000u), __uint_as_float(bw.y << 16), __uint_as_float(bw.y & 0xffff0000u)};
                        const f32x4 o = bb + acc[ai][bj][m][n];
                        u32x2 w; w.x = cvtpk(o[0], o[1]); w.y = cvtpk(o[2], o[3]); *(u32x2*)(xbase + eoff + (ro * 1024 + bj * HALF + n * 16) * 2) = w;
                        q += (o[0] * o[0] + o[1] * o[1]) + (o[2] * o[2] + o[3] * o[3]); }
                q += __shfl_xor(q, 16); q += __shfl_xor(q, 32);
                if (fq == 0) *(float*)(sbase + soff + ro * 64) = q; }
    }
};
template <class Epi, class Sched, bool ALIGN_EPI = false, bool SP2 = false>
__device__ __forceinline__ void gemm_phase(PG8_LAS unsigned char* lds, const Gemm g, const Sched& S, const Epi& E) {
    int tid_ = threadIdx.x; asm volatile("" : "+v"(tid_));
    const int tid = tid_, wid = __builtin_amdgcn_readfirstlane(tid >> 6), lane = tid & 63, wr = wid >> 2, wc = wid & 3, fr = lane & 15, fq = lane >> 4;
    const int K = g.K, nt = K / BK;
    unsigned voffA[2], voffB[2];
#pragma unroll
    for (int i = 0; i < 2; ++i) { int R, C; stage_rc(tid * 16 + i * 8192, R, C); const int Rb = Epi::PERM ? ((R & ~31) + perm32(R & 31)) : R;
        voffA[i] = (unsigned)(R * K + C) * 2u; voffB[i] = (unsigned)(Rb * K + C) * 2u; }
    const size_t kstep = (size_t)(BK * 2);
    const size_t hstep = (size_t)HALF * K * 2;
    const size_t tstep = 2 * hstep;
    const unsigned ldsw = (unsigned)wid * 1024u;
    const int aoff = lds_byte(wr * 64 + fr, fq * 8), boff = lds_byte(wc * 32 + fr, fq * 8);
#define PG8_SA(b, h) (((b) * 2 + (h)) * HTB)
#define PG8_SB(b, h) ((4 + (b) * 2 + (h)) * HTB)
#define PG8_STAGE(bufoff, gbase, voff) do { _Pragma("unroll") for (int _i = 0; _i < 2; ++_i) \
        __builtin_amdgcn_global_load_lds((const unsigned*)((const char*)(gbase) + (voff)[_i]), (PG8_LAS unsigned*)(lds + (bufoff) + ldsw + _i * 8192), 16, 0, 0); } while (0)
#define PG8_LDA(dst, b, h) do { _Pragma("unroll") for (int m = 0; m < 4; ++m) _Pragma("unroll") for (int k = 0; k < 2; ++k) dst[m][k] = *(const PG8_LAS bf16x8*)(lds + PG8_SA(b, h) + aoff + m * 2048 + k * 1024); } while (0)
#define PG8_LDB(dst, b, h) do { _Pragma("unroll") for (int n = 0; n < 2; ++n) _Pragma("unroll") for (int k = 0; k < 2; ++k) dst[n][k] = *(const PG8_LAS bf16x8*)(lds + PG8_SB(b, h) + boff + n * 2048 + k * 1024); } while (0)
#define PG8_MMA(ai, bj, At, Bt) do { __builtin_amdgcn_s_setprio(1); _Pragma("unroll") for (int m = 0; m < 4; ++m) _Pragma("unroll") for (int n = 0; n < 2; ++n) _Pragma("unroll") for (int k = 0; k < 2; ++k) \
        acc[ai][bj][m][n] = __builtin_amdgcn_mfma_f32_16x16x32_bf16(Bt[n][k], At[m][k], acc[ai][bj][m][n], 0, 0, 0); __builtin_amdgcn_s_setprio(0); } while (0)
#define PG8_WAIT_V(n) asm volatile("s_waitcnt vmcnt(" #n ")" ::: "memory")
#define PG8_WAIT_L(n) asm volatile("s_waitcnt lgkmcnt(" #n ")" ::: "memory")
#define PG8_BAR __builtin_amdgcn_s_barrier()
#define PG8_SCHED __builtin_amdgcn_sched_barrier(0)
    Unit cur, nxt; int ui = 0;
    if (!S.next(0, cur)) return;
    f32x4 acc[2][2][4][2];
#pragma unroll
    for (int a = 0; a < 2; ++a)
#pragma unroll
        for (int b = 0; b < 2; ++b)
#pragma unroll
            for (int m = 0; m < 4; ++m)
#pragma unroll
                for (int n = 0; n < 2; ++n) acc[a][b][m][n] = (f32x4){0.f, 0.f, 0.f, 0.f};
    bf16x8 At[4][2], B0[2][2], B1[2][2];
    const char* cA = (const char*)g.A + (size_t)cur.pm * tstep; const char* cB = (const char*)g.Bt + (size_t)cur.pn * tstep;
    S.a_ready(cur);
    if constexpr (SP2) {
        PG8_STAGE(PG8_SB(0, 0), cB, voffB); PG8_STAGE(PG8_SB(0, 1), cB + hstep, voffB); PG8_STAGE(PG8_SA(0, 0), cA, voffA); PG8_STAGE(PG8_SA(0, 1), cA + hstep, voffA);
        if (wr == 1) PG8_BAR;
        PG8_WAIT_V(2); PG8_BAR;
        PG8_STAGE(PG8_SB(1, 0), cB + kstep, voffB); PG8_STAGE(PG8_SA(1, 0), cA + kstep, voffA); PG8_STAGE(PG8_SB(1, 1), cB + hstep + kstep, voffB);
        PG8_WAIT_V(6); PG8_BAR;
    } else {
        PG8_STAGE(PG8_SB(0, 0), cB, voffB); PG8_STAGE(PG8_SA(0, 0), cA, voffA); PG8_STAGE(PG8_SB(0, 1), cB + hstep, voffB); PG8_STAGE(PG8_SA(0, 1), cA + hstep, voffA);
        if (wr == 1) PG8_BAR;
        PG8_WAIT_V(4); PG8_BAR;
        PG8_STAGE(PG8_SB(1, 0), cB + kstep, voffB); PG8_STAGE(PG8_SA(1, 0), cA + kstep, voffA); PG8_STAGE(PG8_SB(1, 1), cB + hstep + kstep, voffB);
        PG8_WAIT_V(6); PG8_BAR;
    }
    for (;;) {
        const bool has_next = S.next(ui + 1, nxt);
        const char* nA = has_next ? (const char*)g.A + (size_t)nxt.pm * tstep : cA; const char* nB = has_next ? (const char*)g.Bt + (size_t)nxt.pn * tstep : cB;
        for (int t = 0; t < nt; t += 2) {
            const bool last = (t == nt - 2);
            const char* a1 = cA + (size_t)(t + 1) * kstep;
            const char* a2 = last ? nA : cA + (size_t)(t + 2) * kstep; const char* b2 = last ? nB : cB + (size_t)(t + 2) * kstep;
            const char* a3 = a2 + kstep; const char* b3 = b2 + kstep;
            if (last && has_next) S.a_ready(nxt);
            if constexpr (SP2) {
            PG8_LDB(B0, 0, 0); PG8_LDB(B1, 0, 1); PG8_SCHED; PG8_LDA(At, 0, 0); PG8_STAGE(PG8_SA(1, 1), a1 + hstep, voffA);
            PG8_WAIT_V(8); PG8_WAIT_L(0); PG8_BAR; PG8_MMA(0, 0, At, B0); PG8_MMA(0, 1, At, B1); PG8_BAR; PG8_SCHED;
            PG8_LDA(At, 0, 1); PG8_STAGE(PG8_SB(0, 0), b2, voffB); PG8_STAGE(PG8_SB(0, 1), b2 + hstep, voffB); PG8_STAGE(PG8_SA(0, 0), a2, voffA);
            PG8_WAIT_V(8); PG8_WAIT_L(0); PG8_BAR; PG8_MMA(1, 0, At, B0); PG8_MMA(1, 1, At, B1); PG8_BAR; PG8_SCHED;
            PG8_LDB(B0, 1, 0); PG8_LDB(B1, 1, 1); PG8_SCHED; PG8_LDA(At, 1, 0); PG8_STAGE(PG8_SA(0, 1), a2 + hstep, voffA);
            PG8_WAIT_V(8); PG8_WAIT_L(0); PG8_BAR; PG8_MMA(0, 0, At, B0); PG8_MMA(0, 1, At, B1); PG8_BAR; PG8_SCHED;
            PG8_LDA(At, 1, 1); PG8_STAGE(PG8_SB(1, 0), b3, voffB); PG8_STAGE(PG8_SB(1, 1), b3 + hstep, voffB); PG8_STAGE(PG8_SA(1, 0), a3, voffA);
            PG8_WAIT_V(8); PG8_WAIT_L(0); PG8_BAR; PG8_MMA(1, 0, At, B0); PG8_MMA(1, 1, At, B1); PG8_BAR; PG8_SCHED;
            } else {
            PG8_LDB(B0, 0, 0); PG8_SCHED; PG8_LDA(At, 0, 0); PG8_STAGE(PG8_SA(1, 1), a1 + hstep, voffA);
            PG8_WAIT_L(8); PG8_BAR; PG8_WAIT_L(0); PG8_MMA(0, 0, At, B0); PG8_BAR; PG8_SCHED;
            PG8_LDB(B1, 0, 1); PG8_STAGE(PG8_SB(0, 0), b2, voffB);
            PG8_BAR; PG8_WAIT_L(0); PG8_MMA(0, 1, At, B1); PG8_BAR;
            PG8_LDA(At, 0, 1); PG8_STAGE(PG8_SA(0, 0), a2, voffA);
            PG8_BAR; PG8_WAIT_L(0); PG8_MMA(1, 0, At, B0); PG8_BAR; PG8_SCHED;
            PG8_STAGE(PG8_SB(0, 1), b2 + hstep, voffB);
            PG8_WAIT_V(6); PG8_BAR; PG8_MMA(1, 1, At, B1); PG8_BAR;
            PG8_LDB(B0, 1, 0); PG8_SCHED; PG8_LDA(At, 1, 0); PG8_STAGE(PG8_SA(0, 1), a2 + hstep, voffA);
            PG8_WAIT_L(8); PG8_BAR; PG8_WAIT_L(0); PG8_MMA(0, 0, At, B0); PG8_BAR; PG8_SCHED;
            PG8_LDB(B1, 1, 1); PG8_STAGE(PG8_SB(1, 0), b3, voffB);
            PG8_BAR; PG8_WAIT_L(0); PG8_MMA(0, 1, At, B1); PG8_BAR;
            PG8_LDA(At, 1, 1); PG8_STAGE(PG8_SA(1, 0), a3, voffA);
            PG8_BAR; PG8_WAIT_L(0); PG8_MMA(1, 0, At, B0); PG8_BAR; PG8_SCHED;
            PG8_STAGE(PG8_SB(1, 1), b3 + hstep, voffB);
            PG8_WAIT_V(6); PG8_BAR; PG8_MMA(1, 1, At, B1); PG8_BAR;
            }
        }
        if constexpr (ALIGN_EPI) { if (wr == 0) PG8_BAR; }
        if constexpr (!Epi::AFTER_DRAIN) { E(acc, cur, wr, wc, fr, fq); S.done(cur); }
        if (!has_next) break;
#pragma unroll
        for (int a = 0; a < 2; ++a)
#pragma unroll
            for (int b = 0; b < 2; ++b)
#pragma unroll
                for (int m = 0; m < 4; ++m)
#pragma unroll
                    for (int n = 0; n < 2; ++n) acc[a][b][m][n] = (f32x4){0.f, 0.f, 0.f, 0.f};
        cur = nxt; cA = nA; cB = nB; ++ui;
        if constexpr (ALIGN_EPI) { if (wr == 1) PG8_BAR; }
    }
    PG8_WAIT_V(0);
    if constexpr (!ALIGN_EPI) { if (wr == 0) PG8_BAR; }
    PG8_BAR;
    if constexpr (Epi::AFTER_DRAIN) { E.fused(acc, cur, wr, wc, fr, fq, lds, wid, lane); S.done(cur); }
#undef PG8_SA
#undef PG8_SB
#undef PG8_STAGE
#undef PG8_LDA
#undef PG8_LDB
#undef PG8_MMA
#undef PG8_WAIT_V
#undef PG8_WAIT_L
#undef PG8_BAR
#undef PG8_SCHED
}
}

constexpr int BATCH = 2, SEQ = 16384, DM = 1024, DEPTH = 4, M_TOK = BATCH * SEQ;
constexpr int PW = 2816;
constexpr int COL_K = 512, COL_V = 1024, COL_BG = 1536, COL_CG = 1792, COL_XH = 2048, COL_SU = 2304, COL_SV = 2560;
constexpr int DFF = 4096, NCHUNK = SEQ / 64;
constexpr float LOG2E = 1.4426950408889634f;
constexpr float QSCALE = 0.125f * LOG2E;
constexpr float EPS = 1e-6f;

#define LAS __attribute__((address_space(3)))
typedef unsigned short bf16;
typedef short bf16x8 __attribute__((ext_vector_type(8)));
typedef short s16x4 __attribute__((ext_vector_type(4)));
typedef float f32x4 __attribute__((ext_vector_type(4)));
typedef float f32x2 __attribute__((ext_vector_type(2)));
typedef unsigned u32x4 __attribute__((ext_vector_type(4)));
typedef unsigned u32x2 __attribute__((ext_vector_type(2)));
using pg8::cvtpk;

__device__ __forceinline__ float bf_lo(unsigned w) { return __uint_as_float(w << 16); }
__device__ __forceinline__ float bf_hi(unsigned w) { return __uint_as_float(w & 0xffff0000u); }
__device__ __forceinline__ s16x4 tr_read(const LAS unsigned char* p) { return __builtin_bit_cast(s16x4, __builtin_amdgcn_ds_read_tr16_b64_v4i16((LAS s16x4*)p)); }
__device__ __forceinline__ bf16x8 cat8(s16x4 lo, s16x4 hi) { return __builtin_shufflevector(lo, hi, 0, 1, 2, 3, 4, 5, 6, 7); }
#define MFMA16(a, b, c) __builtin_amdgcn_mfma_f32_16x16x32_bf16((a), (b), (c), 0, 0, 0)

constexpr int VP = 144;
constexpr int ATT_WAVE_LDS = 64 * VP + 1040;
__device__ __forceinline__ void att_load_k(bf16x8 (&k)[4][2], const bf16* kb, int fr, int fq) {
#pragma unroll
    for (int kt = 0; kt < 4; ++kt)
#pragma unroll
        for (int ks = 0; ks < 2; ++ks) k[kt][ks] = *(const bf16x8*)(kb + (size_t)(kt * 16 + fr) * PW + ks * 32 + fq * 8);
}
__device__ __forceinline__ void att_load_v(u32x4 (&v)[8], const bf16* vb, int lane) {
#pragma unroll
    for (int i = 0; i < 8; ++i) v[i] = *(const u32x4*)(vb + (size_t)(i * 8 + (lane >> 3)) * PW + (lane & 7) * 8);
}
__device__ __forceinline__ void att_store_v(LAS unsigned char* Vl, const u32x4 (&v)[8], int lane) {
#pragma unroll
    for (int i = 0; i < 8; ++i) *(LAS u32x4*)(Vl + (i * 8 + (lane >> 3)) * VP + (lane & 7) * 16) = v[i];
}
__device__ __forceinline__ void attn_item(const bf16* proj, bf16* mixed, const float* relb, int b, int c, int hg, LAS unsigned char* lds, int wid, int lane) {
    const int h = hg * 4 + (wid >> 1), qh = wid & 1, fr = lane & 15, fq = lane >> 4;
    LAS unsigned char* Vl = lds + wid * ATT_WAVE_LDS;
    LAS float* tb = (LAS float*)(Vl + 64 * VP);
    const size_t tokq = (size_t)b * SEQ + (size_t)c * 64 + qh * 32;
    bf16x8 qf[2][2];
#pragma unroll
    for (int qt = 0; qt < 2; ++qt)
#pragma unroll
        for (int ks = 0; ks < 2; ++ks) qf[qt][ks] = *(const bf16x8*)(proj + (tokq + qt * 16 + fr) * PW + h * 64 + ks * 32 + fq * 8);
    for (int i = lane; i < 257; i += 64) tb[i] = relb[h * 257 + i] * LOG2E;
    float mrun[2] = {-1e30f, -1e30f}, lrun[2] = {0.f, 0.f};
    f32x4 o[4][2];
#pragma unroll
    for (int dt = 0; dt < 4; ++dt)
#pragma unroll
        for (int qt = 0; qt < 2; ++qt) o[dt][qt] = (f32x4){0.f, 0.f, 0.f, 0.f};
    const int j0 = (c < 8) ? 8 - c : 0;
    const bf16* kbase = proj + ((size_t)b * SEQ) * PW + COL_K + h * 64;
    bf16x8 kf[4][2]; u32x4 vn[8];
    { const bf16* kb = kbase + (size_t)(c - 8 + j0) * 64 * PW; att_load_k(kf, kb, fr, fq); att_load_v(vn, kb + (COL_V - COL_K), lane); }
    att_store_v(Vl, vn, lane);
    asm volatile("" ::: "memory");
    const int iq0 = qh * 32 + fr;
    for (int j = j0; j <= 8; ++j) {
        bf16x8 kn[4][2];
        { const int jn = (j < 8) ? j + 1 : 8; const bf16* kb = kbase + (size_t)(c - 8 + jn) * 64 * PW; att_load_k(kn, kb, fr, fq); att_load_v(vn, kb + (COL_V - COL_K), lane); }
        f32x4 s[4][2];
#pragma unroll
        for (int kt = 0; kt < 4; ++kt)
#pragma unroll
            for (int qt = 0; qt < 2; ++qt) { f32x4 a = (f32x4){0.f, 0.f, 0.f, 0.f}; a = MFMA16(kf[kt][0], qf[qt][0], a); a = MFMA16(kf[kt][1], qf[qt][1], a); s[kt][qt] = a; }
        if (j <= 5) { const float bc = tb[256];
#pragma unroll
            for (int kt = 0; kt < 4; ++kt)
#pragma unroll
                for (int qt = 0; qt < 2; ++qt) s[kt][qt] = s[kt][qt] + bc;
        } else { const int cb = 512 - 64 * j;
#pragma unroll
            for (int kt = 0; kt < 4; ++kt)
#pragma unroll
                for (int qt = 0; qt < 2; ++qt)
#pragma unroll
                    for (int r = 0; r < 4; ++r) { int rel = (iq0 + qt * 16) - (kt * 16 + 4 * fq + r) + cb; rel = rel < -128 ? -128 : (rel > 128 ? 128 : rel); s[kt][qt][r] += tb[rel + 128]; }
        }
        bf16x8 pf[2][2];
#pragma unroll
        for (int qt = 0; qt < 2; ++qt) {
            float mx = s[0][qt][0];
#pragma unroll
            for (int kt = 0; kt < 4; ++kt)
#pragma unroll
                for (int r = 0; r < 4; ++r) mx = fmaxf(mx, s[kt][qt][r]);
            mx = fmaxf(mx, __shfl_xor(mx, 16)); mx = fmaxf(mx, __shfl_xor(mx, 32));
            const float mn = fmaxf(mrun[qt], mx), al = __builtin_amdgcn_exp2f(mrun[qt] - mn); mrun[qt] = mn;
            float ps = 0.f;
#pragma unroll
            for (int kt = 0; kt < 4; ++kt)
#pragma unroll
                for (int r = 0; r < 4; ++r) { const float p = __builtin_amdgcn_exp2f(s[kt][qt][r] - mn); s[kt][qt][r] = p; ps += p; }
            lrun[qt] = lrun[qt] * al + ps;
#pragma unroll
            for (int dt = 0; dt < 4; ++dt) o[dt][qt] = o[dt][qt] * al;
#pragma unroll
            for (int s2 = 0; s2 < 2; ++s2) { u32x4 w; w.x = cvtpk(s[2 * s2][qt][0], s[2 * s2][qt][1]); w.y = cvtpk(s[2 * s2][qt][2], s[2 * s2][qt][3]);
                w.z = cvtpk(s[2 * s2 + 1][qt][0], s[2 * s2 + 1][qt][1]); w.w = cvtpk(s[2 * s2 + 1][qt][2], s[2 * s2 + 1][qt][3]); pf[qt][s2] = __builtin_bit_cast(bf16x8, w); }
        }
        const LAS unsigned char* vrd = Vl + (4 * fq + (fr >> 2)) * VP + (lane & 3) * 8;
#pragma unroll
        for (int s2 = 0; s2 < 2; ++s2)
#pragma unroll
            for (int dt = 0; dt < 4; ++dt) {
                const s16x4 lo = tr_read(vrd + (32 * s2) * VP + dt * 32), hi = tr_read(vrd + (32 * s2 + 16) * VP + dt * 32);
                const bf16x8 vf = cat8(lo, hi);
#pragma unroll
                for (int qt = 0; qt < 2; ++qt) o[dt][qt] = MFMA16(vf, pf[qt][s2], o[dt][qt]);
            }
        asm volatile("" ::: "memory");
        att_store_v(Vl, vn, lane);
        asm volatile("" ::: "memory");
#pragma unroll
        for (int kt = 0; kt < 4; ++kt)
#pragma unroll
            for (int ks = 0; ks < 2; ++ks) kf[kt][ks] = kn[kt][ks];
    }
#pragma unroll
    for (int qt = 0; qt < 2; ++qt) {
        float l = lrun[qt]; l += __shfl_xor(l, 16); l += __shfl_xor(l, 32);
        const float inv = 1.0f / l; float q = 0.f;
#pragma unroll
        for (int dt = 0; dt < 4; ++dt) { o[dt][qt] = o[dt][qt] * inv; const f32x4 v = o[dt][qt]; q += (v[0] * v[0] + v[1] * v[1]) + (v[2] * v[2] + v[3] * v[3]); }
        q += __shfl_xor(q, 16); q += __shfl_xor(q, 32);
        const float rs = __builtin_amdgcn_rsqf(q * (1.0f / 64.0f) + EPS);
        bf16* op = mixed + (tokq + qt * 16 + fr) * DM + h * 64 + 4 * fq;
#pragma unroll
        for (int dt = 0; dt < 4; ++dt) { const f32x4 v = o[dt][qt] * rs; u32x2 w; w.x = cvtpk(v[0], v[1]); w.y = cvtpk(v[2], v[3]); *(u32x2*)(op + dt * 16) = w; }
    }
}

constexpr int ATT_SLOT = 16384, ATT_TB_OFF = 4 * ATT_SLOT;
__device__ __forceinline__ int att_swz(int row) { return (((row >> 1) & 3) << 1) | ((row >> 3) & 1); }
__device__ __forceinline__ void attn_unit2(const bf16* proj, bf16* mixed, const float* relb, int b, int h, int cq, LAS unsigned char* lds, int tid, int wid, int lane) {
    const int fr = lane & 15, fq = lane >> 4, ci = wid >> 1, qh = wid & 1;
    const size_t tokq = (size_t)b * SEQ + (size_t)(cq * 4 + ci) * 64 + qh * 32;
    LAS float* tb = (LAS float*)(lds + ATT_TB_OFF);
    for (int i = tid; i < 257; i += 512) tb[i] = relb[h * 257 + i] * LOG2E;
    bf16x8 qf[2][2];
#pragma unroll
    for (int qt = 0; qt < 2; ++qt)
#pragma unroll
        for (int ks = 0; ks < 2; ++ks) qf[qt][ks] = *(const bf16x8*)(proj + (tokq + qt * 16 + fr) * PW + h * 64 + ks * 32 + fq * 8);
    asm volatile("s_waitcnt vmcnt(0) lgkmcnt(0)" ::: "memory");
    const int srow = 8 * wid + (lane >> 3), sch = (lane & 7) ^ att_swz(srow);
    const bf16* ksrc = proj + ((long)b * SEQ + (long)(4 * cq - 8) * 64 + srow) * PW + COL_K + h * 64 + sch * 8;
    const unsigned ldsw = (unsigned)wid * 1024u;
#define ATT_DMA(t_) do { const int tt_ = (t_) > 11 ? 11 : (t_); const int sl_ = (tt_ & 3) * ATT_SLOT; const bf16* g_ = ksrc + (long)tt_ * 64 * PW; \
        __builtin_amdgcn_global_load_lds((const unsigned*)g_, (LAS unsigned*)(lds + sl_ + ldsw), 16, 0, 0); \
        __builtin_amdgcn_global_load_lds((const unsigned*)(g_ + (COL_V - COL_K)), (LAS unsigned*)(lds + sl_ + 8192 + ldsw), 16, 0, 0); } while (0)
    const int t0 = (cq < 2) ? 8 - 4 * cq : 0;
    ATT_DMA(t0); ATT_DMA(t0 + 1); ATT_DMA(t0 + 2);
    float mrun[2] = {-1e30f, -1e30f}, lrun[2] = {0.f, 0.f};
    f32x4 o[4][2];
#pragma unroll
    for (int dt = 0; dt < 4; ++dt)
#pragma unroll
        for (int qt = 0; qt < 2; ++qt) o[dt][qt] = (f32x4){0.f, 0.f, 0.f, 0.f};
    const int iq0 = qh * 32 + fr;
    const int koff = fr * 128, kswz = att_swz(fr);
    const int vrow = 4 * fq + (fr >> 2), vswz = att_swz(vrow), voff = vrow * 128 + 8 * (fr & 1), vch = (fr & 3) >> 1;
#pragma unroll 1
    for (int t = t0; t < 12; ++t) {
        asm volatile("s_waitcnt vmcnt(4)" ::: "memory");
        __builtin_amdgcn_s_barrier();
        asm volatile("" ::: "memory");
        ATT_DMA(t + 3);
        const int j = t - ci;
        if (j >= 0 && j <= 8) {
            const LAS unsigned char* Ks = lds + (t & 3) * ATT_SLOT; const LAS unsigned char* Vs = Ks + 8192;
            f32x4 s[4][2];
#pragma unroll
            for (int kt = 0; kt < 4; ++kt) {
                const bf16x8 k0 = *(const LAS bf16x8*)(Ks + kt * 2048 + koff + (((0 + fq) ^ kswz) << 4)), k1 = *(const LAS bf16x8*)(Ks + kt * 2048 + koff + (((4 + fq) ^ kswz) << 4));
#pragma unroll
                for (int qt = 0; qt < 2; ++qt) { f32x4 a = (f32x4){0.f, 0.f, 0.f, 0.f}; a = MFMA16(k0, qf[qt][0], a); a = MFMA16(k1, qf[qt][1], a); s[kt][qt] = a; }
            }
            if (j <= 5) { const float bc = tb[256];
#pragma unroll
                for (int kt = 0; kt < 4; ++kt)
#pragma unroll
                    for (int qt = 0; qt < 2; ++qt) s[kt][qt] = s[kt][qt] + bc;
            } else { const int cb = 512 - 64 * j;
#pragma unroll
                for (int kt = 0; kt < 4; ++kt)
#pragma unroll
                    for (int qt = 0; qt < 2; ++qt)
#pragma unroll
                        for (int r = 0; r < 4; ++r) { int rel = (iq0 + qt * 16) - (kt * 16 + 4 * fq + r) + cb; rel = rel < -128 ? -128 : (rel > 128 ? 128 : rel); s[kt][qt][r] += tb[rel + 128]; }
            }
            bf16x8 pf[2][2];
#pragma unroll
            for (int qt = 0; qt < 2; ++qt) {
                float mx = s[0][qt][0];
#pragma unroll
                for (int kt = 0; kt < 4; ++kt)
#pragma unroll
                    for (int r = 0; r < 4; ++r) mx = fmaxf(mx, s[kt][qt][r]);
                mx = fmaxf(mx, __shfl_xor(mx, 16)); mx = fmaxf(mx, __shfl_xor(mx, 32));
                const float mn = fmaxf(mrun[qt], mx), al = __builtin_amdgcn_exp2f(mrun[qt] - mn); mrun[qt] = mn;
                float ps = 0.f;
#pragma unroll
                for (int kt = 0; kt < 4; ++kt)
#pragma unroll
                    for (int r = 0; r < 4; ++r) { const float p = __builtin_amdgcn_exp2f(s[kt][qt][r] - mn); s[kt][qt][r] = p; ps += p; }
                lrun[qt] = lrun[qt] * al + ps;
#pragma unroll
                for (int dt = 0; dt < 4; ++dt) o[dt][qt] = o[dt][qt] * al;
#pragma unroll
                for (int s2 = 0; s2 < 2; ++s2) { u32x4 w; w.x = cvtpk(s[2 * s2][qt][0], s[2 * s2][qt][1]); w.y = cvtpk(s[2 * s2][qt][2], s[2 * s2][qt][3]);
                    w.z = cvtpk(s[2 * s2 + 1][qt][0], s[2 * s2 + 1][qt][1]); w.w = cvtpk(s[2 * s2 + 1][qt][2], s[2 * s2 + 1][qt][3]); pf[qt][s2] = __builtin_bit_cast(bf16x8, w); }
            }
#pragma unroll
            for (int s2 = 0; s2 < 2; ++s2) {
                s16x4 lo[4], hi[4];
#pragma unroll
                for (int dt = 0; dt < 4; ++dt) { const unsigned va = (unsigned)(uintptr_t)(Vs + voff) + (unsigned)(((2 * dt + vch) ^ vswz) << 4);
                    asm volatile("ds_read_b64_tr_b16 %0, %1 offset:%c2" : "=&v"(lo[dt]) : "v"(va), "i"((32 * s2) * 128) : "memory");
                    asm volatile("ds_read_b64_tr_b16 %0, %1 offset:%c2" : "=&v"(hi[dt]) : "v"(va), "i"((32 * s2 + 16) * 128) : "memory"); }
                asm volatile("s_waitcnt lgkmcnt(0)" : "+v"(lo[0]), "+v"(hi[0]), "+v"(lo[1]), "+v"(hi[1]), "+v"(lo[2]), "+v"(hi[2]), "+v"(lo[3]), "+v"(hi[3]) :: "memory");
#pragma unroll
                for (int dt = 0; dt < 4; ++dt) { const bf16x8 vf = cat8(lo[dt], hi[dt]);
#pragma unroll
                    for (int qt = 0; qt < 2; ++qt) o[dt][qt] = MFMA16(vf, pf[qt][s2], o[dt][qt]); }
            }
        }
    }
#undef ATT_DMA
#pragma unroll
    for (int qt = 0; qt < 2; ++qt) {
        float l = lrun[qt]; l += __shfl_xor(l, 16); l += __shfl_xor(l, 32);
        const float inv = 1.0f / l; float q = 0.f;
#pragma unroll
        for (int dt = 0; dt < 4; ++dt) { o[dt][qt] = o[dt][qt] * inv; const f32x4 v = o[dt][qt]; q += (v[0] * v[0] + v[1] * v[1]) + (v[2] * v[2] + v[3] * v[3]); }
        q += __shfl_xor(q, 16); q += __shfl_xor(q, 32);
        const float rs = __builtin_amdgcn_rsqf(q * (1.0f / 64.0f) + EPS);
        bf16* op = mixed + (tokq + qt * 16 + fr) * DM + h * 64 + 4 * fq;
#pragma unroll
        for (int dt = 0; dt < 4; ++dt) { const f32x4 v = o[dt][qt] * rs; u32x2 w; w.x = cvtpk(v[0], v[1]); w.y = cvtpk(v[2], v[3]); *(u32x2*)(op + dt * 16) = w; }
    }
    asm volatile("s_waitcnt vmcnt(0) lgkmcnt(0)" ::: "memory"); __builtin_amdgcn_s_barrier(); asm volatile("" ::: "memory");
}

__device__ __forceinline__ void unpack8(float (&f)[8], u32x4 w) { f[0] = bf_lo(w.x); f[1] = bf_hi(w.x); f[2] = bf_lo(w.y); f[3] = bf_hi(w.y); f[4] = bf_lo(w.z); f[5] = bf_hi(w.z); f[6] = bf_lo(w.w); f[7] = bf_hi(w.w); }
__device__ __forceinline__ void conv_item(const bf16* proj, bf16* mixed, const float* cw, int item, int tid) {
    const int oc = tid & 31, c0 = oc * 8;
    float w0[8], w1[8], w2[8];
#pragma unroll
    for (int i = 0; i < 8; ++i) { w0[i] = cw[c0 + i]; w1[i] = cw[256 + c0 + i]; w2[i] = cw[512 + c0 + i]; }
#pragma unroll 1
    for (int pass = 0; pass < 4; ++pass) {
        const int t = item * 64 + pass * 16 + (tid >> 5), ts = t & (SEQ - 1);
        const bf16* rp = proj + (size_t)t * PW + c0;
        float bg[8], z[8], y[8], a[8], x[8];
        unpack8(bg, *(const u32x4*)(rp + COL_BG));
        unpack8(a, *(const u32x4*)(rp + COL_CG)); unpack8(x, *(const u32x4*)(rp + COL_XH));
#pragma unroll
        for (int i = 0; i < 8; ++i) y[i] = w2[i] * (a[i] * x[i]);
        if (ts >= 1) { unpack8(a, *(const u32x4*)(rp - PW + COL_CG)); unpack8(x, *(const u32x4*)(rp - PW + COL_XH));
#pragma unroll
            for (int i = 0; i < 8; ++i) y[i] += w1[i] * (a[i] * x[i]); }
        if (ts >= 2) { unpack8(a, *(const u32x4*)(rp - 2 * PW + COL_CG)); unpack8(x, *(const u32x4*)(rp - 2 * PW + COL_XH));
#pragma unroll
            for (int i = 0; i < 8; ++i) y[i] += w0[i] * (a[i] * x[i]); }
        float q = 0.f;
#pragma unroll
        for (int i = 0; i < 8; ++i) { z[i] = bg[i] * y[i]; q += z[i] * z[i]; }
        q += __shfl_xor(q, 1); q += __shfl_xor(q, 2); q += __shfl_xor(q, 4);
        const float rs = __builtin_amdgcn_rsqf(q * (1.0f / 64.0f) + EPS);
        u32x4 w; w.x = cvtpk(z[0] * rs, z[1] * rs); w.y = cvtpk(z[2] * rs, z[3] * rs); w.z = cvtpk(z[4] * rs, z[5] * rs); w.w = cvtpk(z[6] * rs, z[7] * rs);
        *(u32x4*)(mixed + (size_t)t * DM + 512 + c0) = w;
    }
}

constexpr int GP = 544;
__device__ __forceinline__ void gate_item(const bf16* proj, bf16* mixed, const float* lng, const float* lnb, const bf16* wsb, const float* sgb, int blk, LAS unsigned char* lds, int tid, int wid, int lane) {
    const size_t tok0 = (size_t)blk * 128;
    { const int tk = tid >> 2, part = tid & 3;
        const bf16* rp = proj + (tok0 + tk) * PW + COL_SV + part * 64;
        float x[64];
#pragma unroll
        for (int i = 0; i < 8; ++i) { float f[8]; unpack8(f, *(const u32x4*)(rp + i * 8));
#pragma unroll
            for (int k = 0; k < 8; ++k) x[i * 8 + k] = f[k]; }
        float sm = 0.f;
#pragma unroll
        for (int i = 0; i < 64; ++i) sm += x[i];
        sm += __shfl_xor(sm, 1); sm += __shfl_xor(sm, 2);
        const float mu = sm * (1.0f / 256.0f); float q = 0.f;
#pragma unroll
        for (int i = 0; i < 64; ++i) { x[i] -= mu; q += x[i] * x[i]; }
        q += __shfl_xor(q, 1); q += __shfl_xor(q, 2);
        const float rs = __builtin_amdgcn_rsqf(q * (1.0f / 256.0f) + EPS);
        LAS unsigned char* wp = lds + tk * GP + part * 128;
#pragma unroll
        for (int i = 0; i < 8; ++i) { const f32x4 g0 = *(const f32x4*)(lng + part * 64 + i * 8), g1 = *(const f32x4*)(lng + part * 64 + i * 8 + 4), b0 = *(const f32x4*)(lnb + part * 64 + i * 8), b1 = *(const f32x4*)(lnb + part * 64 + i * 8 + 4);
            u32x4 w; w.x = cvtpk(x[i * 8 + 0] * rs * g0[0] + b0[0], x[i * 8 + 1] * rs * g0[1] + b0[1]); w.y = cvtpk(x[i * 8 + 2] * rs * g0[2] + b0[2], x[i * 8 + 3] * rs * g0[3] + b0[3]);
            w.z = cvtpk(x[i * 8 + 4] * rs * g1[0] + b1[0], x[i * 8 + 5] * rs * g1[1] + b1[1]); w.w = cvtpk(x[i * 8 + 6] * rs * g1[2] + b1[2], x[i * 8 + 7] * rs * g1[3] + b1[3]);
            *(LAS u32x4*)(wp + i * 16) = w; }
    }
    __syncthreads();
    {
        const int g = wid >> 1, th = wid & 1, fr = lane & 15, fq = lane >> 4;
        f32x4 acc[4][4];
#pragma unroll
        for (int ct = 0; ct < 4; ++ct)
#pragma unroll
            for (int tt = 0; tt < 4; ++tt) acc[ct][tt] = (f32x4){0.f, 0.f, 0.f, 0.f};
        const int nks = th ? 4 : 2;
        const LAS unsigned char* vrd = lds + (8 * fq + (fr >> 2)) * GP + g * 128 + (lane & 3) * 8;
        const bf16* wrow = wsb + ((size_t)g * 128 + th * 64 + fr) * 128 + 8 * fq;
#pragma unroll 1
        for (int ks = 0; ks < nks; ++ks) {
            bf16x8 vf[4];
#pragma unroll
            for (int ct = 0; ct < 4; ++ct) { const s16x4 lo = tr_read(vrd + (32 * ks) * GP + ct * 32), hi = tr_read(vrd + (32 * ks + 4) * GP + ct * 32); vf[ct] = cat8(lo, hi); }
#pragma unroll
            for (int tt = 0; tt < 4; ++tt) { const bf16x8 wf = *(const bf16x8*)(wrow + (size_t)(tt * 16) * 128 + ks * 32);
#pragma unroll
                for (int ct = 0; ct < 4; ++ct) acc[ct][tt] = MFMA16(vf[ct], wf, acc[ct][tt]); }
        }
#pragma unroll
        for (int tt = 0; tt < 4; ++tt) { const int t = th * 64 + tt * 16 + fr; const float bias = sgb[g * 128 + t];
            const bf16* up = proj + (tok0 + t) * PW + COL_SU + g * 64 + 4 * fq; float q = 0.f; f32x4 v[4];
#pragma unroll
            for (int ct = 0; ct < 4; ++ct) { const u32x2 uw = *(const u32x2*)(up + ct * 16); const f32x4 uu = (f32x4){bf_lo(uw.x), bf_hi(uw.x), bf_lo(uw.y), bf_hi(uw.y)};
                v[ct] = uu * (acc[ct][tt] + bias); q += (v[ct][0] * v[ct][0] + v[ct][1] * v[ct][1]) + (v[ct][2] * v[ct][2] + v[ct][3] * v[ct][3]); }
            q += __shfl_xor(q, 16); q += __shfl_xor(q, 32);
            const float rs = __builtin_amdgcn_rsqf(q * (1.0f / 64.0f) + EPS);
            bf16* op = mixed + (tok0 + t) * DM + 768 + g * 64 + 4 * fq;
#pragma unroll
            for (int ct = 0; ct < 4; ++ct) { const f32x4 r = v[ct] * rs; u32x2 w; w.x = cvtpk(r[0], r[1]); w.y = cvtpk(r[2], r[3]); *(u32x2*)(op + ct * 16) = w; }
        }
    }
    __syncthreads();
}

constexpr size_t MiB = 1u << 20;
constexpr size_t SZ_WIN = (size_t)PW * DM * 2, SZ_WOUT = (size_t)DM * DM * 2, SZ_WUP = (size_t)DFF * DM * 2, SZ_WDN = (size_t)DM * DFF * 2, SZ_WSG = (size_t)4 * 128 * 128 * 2;
constexpr size_t WS_WIN = 0;
constexpr size_t WS_WOUT = WS_WIN + DEPTH * SZ_WIN;
constexpr size_t WS_WUP = WS_WOUT + DEPTH * SZ_WOUT;
constexpr size_t WS_WDN = WS_WUP + DEPTH * SZ_WUP;
constexpr size_t WS_WSG = WS_WDN + DEPTH * SZ_WDN;
constexpr size_t WS_SS = WS_WSG + DEPTH * SZ_WSG;
constexpr size_t WS_XB = WS_SS + (size_t)M_TOK * 16 * 4;
constexpr size_t WS_PROJ = WS_XB + (size_t)M_TOK * DM * 2;
constexpr size_t WS_MIX = WS_PROJ + (size_t)M_TOK * PW * 2;
constexpr size_t WS_HDN = WS_PROJ;
constexpr size_t WS_CTL = WS_HDN + (size_t)M_TOK * DFF * 2, CTL_BYTES = 65536;
constexpr size_t WS_END = WS_CTL + CTL_BYTES;
static_assert(WS_MIX + (size_t)M_TOK * DM * 2 <= WS_CTL, "hdn covers proj + mixed");
static_assert(WS_WOUT % 256 == 0 && WS_WUP % 256 == 0 && WS_WDN % 256 == 0 && WS_WSG % 256 == 0 && WS_SS % 256 == 0 && WS_XB % 256 == 0 && WS_PROJ % 256 == 0 && WS_MIX % 256 == 0, "alignment");

constexpr int NWAVES = 8;
constexpr int LDS_BYTES = 132096;
static_assert(8 * ATT_WAVE_LDS <= 131072 && 128 * GP <= 131072, "LDS map");

#define XB_TMO      128
#define XB_XCNT(j)  (256  + 64 * (j))
#define XB_XSUB(j)  (1280 + 64 * (j))
#define XB_XGEN(j)  (2304 + 64 * (j))
#define XB_TOP      3328
#define XB_TOPGEN   3392
#define XCD_BAR_WORDS 3456
#define XB_SPIN_CAP (1u << 18)

__device__ __forceinline__ unsigned xb_ld(unsigned* p)              { return __hip_atomic_load(p, __ATOMIC_RELAXED, __HIP_MEMORY_SCOPE_AGENT); }
__device__ __forceinline__ unsigned xb_add(unsigned* p, unsigned v) { return __hip_atomic_fetch_add(p, v, __ATOMIC_RELAXED, __HIP_MEMORY_SCOPE_AGENT); }
__device__ __forceinline__ unsigned xb_xcc_id() { return (unsigned)__builtin_amdgcn_s_getreg((3 << 11) | 20) & 0xFu; }
#define XB_SPIN(cond, bar) do { unsigned _sp = 0; while (cond) { __builtin_amdgcn_s_sleep(1); \
    if ((++_sp & 255u) == 0u) { if (xb_ld(&(bar)[XB_TMO])) break; if (_sp > XB_SPIN_CAP) { atomicAdd(&(bar)[XB_TMO], 1u); break; } } } } while (0)

struct XcdBarrier {
    unsigned* bar; unsigned x;
    volatile LAS unsigned* st;
};

__device__ __forceinline__ XcdBarrier xcd_barrier_post(unsigned* bar, volatile LAS unsigned* st) {
    XcdBarrier b; b.bar = bar; b.x = xb_xcc_id(); b.st = st;
    if (threadIdx.x == 0) (void)xb_add(&bar[XB_XCNT(b.x)], 1u);
    return b;
}
__device__ __forceinline__ void xcd_barrier_complete(unsigned* bar, unsigned x, unsigned& nloc, unsigned& nx) {
    const unsigned G = gridDim.x * gridDim.y * gridDim.z;
    unsigned sum, cnt, mine, sp = 0u;
    for (;;) {
        sum = 0u; cnt = 0u; mine = 0u;
#pragma unroll
        for (unsigned j = 0; j < 16; ++j) { const unsigned c = xb_ld(&bar[XB_XCNT(j)]); sum += c; cnt += (c > 0u) ? 1u : 0u; mine = (j == x) ? c : mine; }
        if (sum == G) break;
        __builtin_amdgcn_s_sleep(1);
        if ((++sp & 255u) == 0u) { if (xb_ld(&bar[XB_TMO])) break; if (sp > XB_SPIN_CAP) { atomicAdd(&bar[XB_TMO], 1u); break; } }
    }
    nloc = mine > 0u ? mine : 1u; nx = cnt > 0u ? cnt : 1u;
}

__device__ __forceinline__ void xcd_barrier(const XcdBarrier& b) {
    asm volatile("s_waitcnt vmcnt(0)" ::: "memory");
    __syncthreads();
    if (threadIdx.x == 0) {
        unsigned* bar = b.bar;
        __builtin_amdgcn_s_waitcnt(0);
        unsigned nloc = b.st[0], nx = b.st[1];
        if (nloc == 0u) { xcd_barrier_complete(bar, b.x, nloc, nx); b.st[0] = nloc; b.st[1] = nx; }
        const unsigned old = xb_add(&bar[XB_XSUB(b.x)], 1u);
        const unsigned gen = old / nloc;
        if (old + 1u == (gen + 1u) * nloc) {
            __builtin_amdgcn_fence(__ATOMIC_RELEASE, "agent");
            asm volatile("s_waitcnt vmcnt(0)" ::: "memory");
            const unsigned og = xb_add(&bar[XB_TOP], 1u);
            const unsigned tg = og / nx;
            if (og + 1u == (tg + 1u) * nx) xb_add(&bar[XB_TOPGEN], 1u);
            else XB_SPIN(xb_ld(&bar[XB_TOPGEN]) == tg, bar);
            __builtin_amdgcn_fence(__ATOMIC_ACQUIRE, "agent");
            xb_add(&bar[XB_XGEN(b.x)], 1u);
            asm volatile("s_waitcnt vmcnt(0)" ::: "memory");
        } else {
            XB_SPIN(xb_ld(&bar[XB_XGEN(b.x)]) == gen, bar);
            __builtin_amdgcn_fence(__ATOMIC_ACQUIRE, "agent");
            asm volatile("s_waitcnt vmcnt(0)" ::: "memory");
        }
    }
    __syncthreads();
}

__device__ __forceinline__ unsigned f2bf(float f) { unsigned u = __builtin_bit_cast(unsigned, f); return (u + 0x7fffu + ((u >> 16) & 1u)) >> 16; }
__device__ __forceinline__ unsigned pk2(float lo, float hi) { return f2bf(lo) | (f2bf(hi) << 16); }
__device__ __forceinline__ float wave_sum(float v) {
#pragma unroll
    for (int o = 1; o < 64; o <<= 1) v += __shfl_xor(v, o);
    return v;
}
__device__ __forceinline__ void p0_transpose_item(const float* W, const float* gain, int K, int N, bf16* WT, LAS float* scr, int item, int lane) {
    const int nblk = N / 32, kb = item / nblk, nb = item % nblk, k0 = 64 * kb, n0 = 32 * nb;
#pragma unroll 8
    for (int i = 0; i < 32; ++i) { const int kk = 2 * i + (lane >> 5); const float gsc = gain ? gain[k0 + kk] : 1.0f; scr[kk * 33 + (lane & 31)] = W[(size_t)(k0 + kk) * N + n0 + (lane & 31)] * gsc; }
    asm volatile("s_waitcnt lgkmcnt(0)" ::: "memory");
    const int c = lane & 7;
#pragma unroll
    for (int j = 0; j < 4; ++j) { const int n = (lane >> 3) + 8 * j; const LAS float* s = scr + (8 * c) * 33 + n;
        u32x4 o; o.x = pk2(s[0 * 33], s[1 * 33]); o.y = pk2(s[2 * 33], s[3 * 33]); o.z = pk2(s[4 * 33], s[5 * 33]); o.w = pk2(s[6 * 33], s[7 * 33]);
        *(u32x4*)(WT + (size_t)(n0 + n) * K + k0 + 8 * c) = o; }
    asm volatile("s_waitcnt lgkmcnt(0)" ::: "memory");
}

struct Args { const float* in[15]; float* out; unsigned char* ws; };

__global__ void __launch_bounds__(NWAVES * 64, 2) trunk_fwd(Args args) {
    extern __shared__ __attribute__((aligned(16))) unsigned char lds_raw[];
    cg::grid_group grid = cg::this_grid();
    LAS unsigned char* lds = (LAS unsigned char*)lds_raw;
    const int G = gridDim.x, bx = blockIdx.x;
    const int vcu = (G % 8 == 0) ? (bx % 8) * (G / 8) + bx / 8 : bx;
    unsigned char* ws = args.ws;
    if (threadIdx.x < 64) ((LAS unsigned*)(lds + 131072))[threadIdx.x] = 0u;
    __syncthreads();
    const XcdBarrier bar = xcd_barrier_post((unsigned*)(ws + WS_CTL), (volatile LAS unsigned*)(lds + 131072));
    const float* x_in = args.in[0];
    float* X = args.out;
    bf16* XB = (bf16*)(ws + WS_XB); float* SS = (float*)(ws + WS_SS);
    bf16* PROJ = (bf16*)(ws + WS_PROJ); bf16* MIXB = (bf16*)(ws + WS_MIX); bf16* HDN = (bf16*)(ws + WS_HDN);

    {
        int tid = threadIdx.x; asm volatile("" : "+v"(tid)); const int lane = tid & 63, wid = __builtin_amdgcn_readfirstlane(tid >> 6);
        LAS float* scr = (LAS float*)(lds + wid * 16384);
        const int gw = vcu * NWAVES + wid, NGW = G * NWAVES;
        constexpr int I_IN = (DM / 64) * (PW / 32), I_OUT = (DM / 64) * (DM / 32), I_UP = (DM / 64) * (DFF / 32), I_DN = (DFF / 64) * (DM / 32), I_L = I_IN + I_OUT + I_UP + I_DN;
        for (int it = gw; it < DEPTH * I_L; it += NGW) {
            const int l = it / I_L; int r = it % I_L;
            if (r < I_IN) { p0_transpose_item(args.in[2] + (size_t)l * DM * PW, args.in[1] + l * DM, DM, PW, (bf16*)(ws + WS_WIN + l * SZ_WIN), scr, r, lane); continue; } r -= I_IN;
            if (r < I_OUT) { p0_transpose_item(args.in[10] + (size_t)l * DM * DM, args.in[9] + l * DM, DM, DM, (bf16*)(ws + WS_WOUT + l * SZ_WOUT), scr, r, lane); continue; } r -= I_OUT;
            if (r < I_UP) { p0_transpose_item(args.in[12] + (size_t)l * DM * DFF, args.in[11] + l * DM, DM, DFF, (bf16*)(ws + WS_WUP + l * SZ_WUP), scr, r, lane); continue; } r -= I_UP;
            p0_transpose_item(args.in[13] + (size_t)l * DFF * DM, nullptr, DFF, DM, (bf16*)(ws + WS_WDN + l * SZ_WDN), scr, r, lane);
        }
        { const float* sw = args.in[7]; bf16* wsg = (bf16*)(ws + WS_WSG);
            for (int i = bx * 512 + tid; i < DEPTH * 4 * 128 * 128 / 2; i += G * 512) { const int e = 2 * i, t = (e >> 7) & 127, s = e & 127; const f32x2 v = *(const f32x2*)(sw + e);
                ((unsigned*)wsg)[i] = pk2(s <= t ? v.x : 0.f, (s + 1) <= t ? v.y : 0.f); } }
        for (int m = gw; m < M_TOK; m += NGW) {
            const f32x4* xr = (const f32x4*)(x_in + (size_t)m * DM) + lane; unsigned long long* o8 = (unsigned long long*)(XB + (size_t)m * DM) + lane; float q = 0.f;
#pragma unroll
            for (int j = 0; j < 4; ++j) { const f32x4 v = xr[64 * j]; q += (v.x * v.x + v.y * v.y) + (v.z * v.z + v.w * v.w); o8[64 * j] = (unsigned long long)pk2(v.x, v.y) | ((unsigned long long)pk2(v.z, v.w) << 32); }
            q = wave_sum(q);
            if (lane < 16) SS[(size_t)m * 16 + lane] = (lane == 0) ? q : 0.f;
        }
    }
    grid.sync();

#pragma unroll 1
    for (int l = 0; l < DEPTH; ++l) {
        {
            pg8::Gemm g{XB, (const bf16*)(ws + WS_WIN + l * SZ_WIN), M_TOK, PW, DM}; pg8::StaticOrder S; S.init(M_TOK, PW, G, bx);
            pg8::EpiAct<0, PW> E{PROJ, SS, QSCALE};
            pg8::gemm_phase<pg8::EpiAct<0, PW>, pg8::StaticOrder, true, true>(lds, g, S, E);
        }
        xcd_barrier(bar);
#ifndef REP_P2
#define REP_P2 1
#endif
#pragma unroll 1
        for (int rep = 0; rep < REP_P2; ++rep) {
            int tid = threadIdx.x; asm volatile("" : "+v"(tid));
            const int lane = tid & 63, wid = __builtin_amdgcn_readfirstlane(tid >> 6);
            const float* relb = args.in[3] + (size_t)l * 8 * 257;
            for (int u = vcu; u < BATCH * 8 * (NCHUNK / 4); u += G) { const int cq = u % (NCHUNK / 4), bh = u / (NCHUNK / 4); attn_unit2(PROJ, MIXB, relb, bh >> 3, bh & 7, cq, lds, tid, wid, lane); }
            for (int u = bx; u < M_TOK / 64; u += G) conv_item(PROJ, MIXB, args.in[4] + (size_t)l * 3 * 256, u, tid);
            __syncthreads();
            for (int u = bx; u < M_TOK / 128; u += G)
                gate_item(PROJ, MIXB, args.in[5] + l * 256, args.in[6] + l * 256, (const bf16*)(ws + WS_WSG + l * SZ_WSG), args.in[8] + l * 512, u, lds, tid, wid, lane);
        }
        xcd_barrier(bar);
        {
            pg8::Gemm g{MIXB, (const bf16*)(ws + WS_WOUT + l * SZ_WOUT), M_TOK, DM, DM}; pg8::StaticOrder S; S.init(M_TOK, DM, G, bx);
            pg8::EpiRes E{XB, SS};
            pg8::gemm_phase<pg8::EpiRes, pg8::StaticOrder, true, true>(lds, g, S, E);
        }
        xcd_barrier(bar);
        {
            pg8::Gemm g{XB, (const bf16*)(ws + WS_WUP + l * SZ_WUP), M_TOK, DFF, DM}; pg8::StaticOrder S; S.init(M_TOK, DFF, G, bx);
            pg8::EpiAct<1, DFF> E{HDN, SS, 1.0f};
            pg8::gemm_phase<pg8::EpiAct<1, DFF>, pg8::StaticOrder, true, true>(lds, g, S, E);
        }
        xcd_barrier(bar);
        {
            pg8::Gemm g{HDN, (const bf16*)(ws + WS_WDN + l * SZ_WDN), M_TOK, DM, DFF}; pg8::StaticOrder S; S.init(M_TOK, DM, G, bx);
            pg8::EpiRes E{XB, SS};
            pg8::gemm_phase<pg8::EpiRes, pg8::StaticOrder, true, true>(lds, g, S, E);
        }
        xcd_barrier(bar);
    }
    {
        int tidf = threadIdx.x; asm volatile("" : "+v"(tidf)); const int lane = tidf & 63, wid = __builtin_amdgcn_readfirstlane(tidf >> 6);
        const int gw = vcu * NWAVES + wid, NGW = G * NWAVES; const f32x4* gp = (const f32x4*)args.in[14] + lane;
        for (int m = gw; m < M_TOK; m += NGW) {
            f32x4* xr = (f32x4*)(X + (size_t)m * DM) + lane; const u32x2* br = (const u32x2*)(XB + (size_t)m * DM) + lane; f32x4 v[4]; float q = 0.f;
#pragma unroll
            for (int j = 0; j < 4; ++j) { const u32x2 w = br[64 * j]; v[j] = (f32x4){bf_lo(w.x), bf_hi(w.x), bf_lo(w.y), bf_hi(w.y)}; q += (v[j].x * v[j].x + v[j].y * v[j].y) + (v[j].z * v[j].z + v[j].w * v[j].w); }
            const float rs = 1.0f / sqrtf(wave_sum(q) * (1.0f / DM) + EPS);
#pragma unroll
            for (int j = 0; j < 4; ++j) xr[64 * j] = v[j] * rs * gp[64 * j];
        }
    }
}

extern "C" void kernel_launch(void* const* d_in, const int* in_sizes, int n_in, void* d_out, int out_size, void* d_ws, size_t ws_size, hipStream_t stream) {
    static int grid = 0;
    if (grid == 0) {
        if (n_in != 15 || in_sizes[0] != M_TOK * DM || out_size != M_TOK * DM || ws_size < WS_END) { fprintf(stderr, "kernel_launch: unexpected shapes (n_in %d, in0 %d, out %d, ws %zu < %zu); nothing launched\n", n_in, n_in > 0 ? in_sizes[0] : -1, out_size, ws_size, (size_t)WS_END); grid = -1; return; }
        int dev = 0, cus = 0, per_cu = 0;
        if (hipGetDevice(&dev) != hipSuccess || hipDeviceGetAttribute(&cus, hipDeviceAttributeMultiprocessorCount, dev) != hipSuccess) { grid = -1; return; }
        if (hipFuncSetAttribute((const void*)trunk_fwd, hipFuncAttributeMaxDynamicSharedMemorySize, LDS_BYTES) != hipSuccess) { fprintf(stderr, "kernel_launch: hipFuncSetAttribute failed\n"); grid = -1; return; }
        if (hipOccupancyMaxActiveBlocksPerMultiprocessor(&per_cu, (const void*)trunk_fwd, NWAVES * 64, LDS_BYTES) != hipSuccess || per_cu < 1) { fprintf(stderr, "kernel_launch: occupancy query says %d blocks per CU\n", per_cu); per_cu = 1; }
        (void)hipGetLastError();
        grid = cus * per_cu;
    }
    if (grid < 0) return;
    if (hipMemsetAsync((char*)d_ws + WS_CTL, 0, CTL_BYTES, stream) != hipSuccess) { fprintf(stderr, "kernel_launch: memset failed\n"); return; }
    Args a{};
    for (int i = 0; i < 15; ++i) a.in[i] = (const float*)d_in[i];
    a.out = (float*)d_out; a.ws = (unsigned char*)d_ws;
    void* kargs[] = {&a};
    hipError_t e = hipLaunchCooperativeKernel((const void*)trunk_fwd, dim3(grid), dim3(NWAVES * 64), kargs, LDS_BYTES, stream);
    if (e != hipSuccess) fprintf(stderr, "kernel_launch: cooperative launch failed: %s (grid %d)\n", hipGetErrorString(e), grid);
}
```

```cpp
#include <hip/hip_runtime.h>
#include <hip/hip_cooperative_groups.h>
#include <cstdio>
#include <cstdint>
namespace cg = cooperative_groups;
namespace pg8 {
#define PG8_LAS __attribute__((address_space(3)))
typedef unsigned short bf16_t;
typedef short bf16x8 __attribute__((ext_vector_type(8)));
typedef float f32x4 __attribute__((ext_vector_type(4)));
typedef unsigned u32x4 __attribute__((ext_vector_type(4)));
constexpr int BM = 256, BK = 64, HALF = 128, HTB = HALF * BK * 2  , STAGE_BYTES = 8 * HTB, NXCD = 8, WGM = 8;

__host__ __device__ __forceinline__ int lds_byte(int r, int c) { const int st = (r >> 4) * 2 + (c >> 5), rr = r & 15, cc = c & 31, ob = rr * 64 + cc * 2; return st * 1024 + (ob ^ (((ob >> 9) & 1) << 5)); }
__host__ __device__ __forceinline__ void stage_rc(int b, int& R, int& C) { const int st = b / 1024, sb = b % 1024, swz = sb ^ (((sb >> 9) & 1) << 5); R = (st >> 1) * 16 + swz / 64; C = (st & 1) * 32 + (swz % 64) / 2; }
__host__ __device__ __forceinline__ int perm32(int rho) { const int n = rho >> 4, i = rho & 15; return 8 * (i >> 2) + 4 * n + (i & 3); }

struct Unit { int pm, pn; };
struct Gemm { const bf16_t* A; const bf16_t* Bt; int M, N, K; };

struct StaticOrder {
    int nM, nN, nwg, G, c;
    __host__ __device__ void init(int M, int N, int G_, int c_) { nM = M / BM; nN = N / BM; nwg = nM * nN; G = G_; c = c_; }
    __host__ __device__ bool next(int i, Unit& u) const {
        const long L = (long)i * G + c; if (L >= nwg) return false;
        int wgid = (int)L; { const int q = nwg / NXCD, r = nwg % NXCD, xcd = wgid % NXCD, off = wgid / NXCD; wgid = (xcd < r ? xcd * (q + 1) : r * (q + 1) + (xcd - r) * q) + off; }
        const int nig = WGM * nN, gid = wgid / nig, fm = gid * WGM, gsz = (nM - fm) < WGM ? (nM - fm) : WGM;
        u.pm = fm + ((wgid % nig) % gsz); u.pn = (wgid % nig) / gsz; return true;
    }
    __device__ __forceinline__ void a_ready(const Unit&) const {}
    __device__ __forceinline__ void done(const Unit&) const {}
};

__device__ __forceinline__ unsigned cvt_pk_bf16(float lo, float hi) { unsigned r; asm volatile("v_cvt_pk_bf16_f32 %0, %1, %2" : "=v"(r) : "v"(lo), "v"(hi)); return r; }
typedef float f32x2 __attribute__((ext_vector_type(2)));
__device__ __forceinline__ f32x2 gelu_pk(f32x2 v) {
    const f32x2 av = __builtin_elementwise_abs(v), d = av * 0.2316418882f + 1.0f;
    f32x2 t; t.x = __builtin_amdgcn_rcpf(d.x); t.y = __builtin_amdgcn_rcpf(d.y);
    f32x2 q = t * 0.5307027145f + (-0.7265760135f); q = q * t + 0.7107068705f; q = q * t + (-0.142248368f); q = q * t + 0.127414796f; q = q * t;
    const f32x2 s = (v * v) * (-0.72134752044f);
    f32x2 e; e.x = __builtin_amdgcn_exp2f(s.x); e.y = __builtin_amdgcn_exp2f(s.y);
    const f32x2 m = v * (q * e), r = v - m;
    f32x2 o; o.x = v.x < 0.f ? m.x : r.x; o.y = v.y < 0.f ? m.y : r.y; return o;
}


typedef unsigned u32x2 __attribute__((ext_vector_type(2)));
typedef __bf16 bf16x2_t __attribute__((ext_vector_type(2)));
__device__ __forceinline__ unsigned cvtpk(float lo, float hi) { f32x2 v = {lo, hi}; bf16x2_t b = __builtin_convertvector(v, bf16x2_t); return __builtin_bit_cast(unsigned, b); }
constexpr float RMS_EPS = 1e-6f;
__device__ __forceinline__ float row_rstd(const char* rec) {
    const f32x4* p = (const f32x4*)rec;
    const f32x4 a = p[0], b = p[1], c = p[2], d = p[3];
    const f32x4 s = (a + b) + (c + d);
    const float t = (s[0] + s[1]) + (s[2] + s[3]);
    return __builtin_amdgcn_rsqf(t * (1.0f / 1024.0f) + RMS_EPS);
}
template <int MODE, int LDC> struct EpiAct {
    static constexpr bool PERM = true, AFTER_DRAIN = false;
    bf16_t* O; const float* ss; float qscale;
    __device__ __forceinline__ void operator()(const f32x4 (&acc)[2][2][4][2], const Unit& u, int wr, int wc, int fr, int fq) const {
        const int rl = wr * 64 + fr;
        unsigned ooff = (unsigned)(rl * LDC + wc * 32 + 8 * fq) * 2u, soff = (unsigned)rl * 64u;
        asm volatile("" : "+v"(ooff), "+v"(soff));
        char* obase = (char*)O + ((size_t)u.pm * BM * LDC + (size_t)u.pn * BM) * 2;
        const char* sbase = (const char*)ss + (size_t)u.pm * BM * 64;
        const float sc = (MODE == 0 && u.pn < 2) ? qscale : 1.0f; const bool act = (MODE == 0 && u.pn >= 9);
#pragma unroll
        for (int ai = 0; ai < 2; ++ai)
#pragma unroll
            for (int m = 0; m < 4; ++m) { const int ro = ai * HALF + m * 16; const float rs = row_rstd(sbase + soff + ro * 64) * sc; char* rowp = obase + ooff + (size_t)ro * LDC * 2;
#pragma unroll
                for (int bj = 0; bj < 2; ++bj) { f32x4 v0 = acc[ai][bj][m][0] * rs, v1 = acc[ai][bj][m][1] * rs;
                    if (MODE == 0) { if (act) { f32x2 a = gelu_pk((f32x2){v0[0], v0[1]}), b = gelu_pk((f32x2){v0[2], v0[3]}), c = gelu_pk((f32x2){v1[0], v1[1]}), d = gelu_pk((f32x2){v1[2], v1[3]});
                        v0 = (f32x4){a.x, a.y, b.x, b.y}; v1 = (f32x4){c.x, c.y, d.x, d.y}; } }
                    else { v0 = __builtin_elementwise_max(v0, (f32x4){0.f, 0.f, 0.f, 0.f}); v1 = __builtin_elementwise_max(v1, (f32x4){0.f, 0.f, 0.f, 0.f}); v0 = v0 * v0; v1 = v1 * v1; }
                    u32x4 w; w.x = cvtpk(v0[0], v0[1]); w.y = cvtpk(v0[2], v0[3]); w.z = cvtpk(v1[0], v1[1]); w.w = cvtpk(v1[2], v1[3]);
                    *(u32x4*)(rowp + bj * HALF * 2) = w; } }
    }
};
struct EpiRes {
    static constexpr bool PERM = false, AFTER_DRAIN = false;
    bf16_t* xb; float* ss;
    __device__ __forceinline__ void operator()(const f32x4 (&acc)[2][2][4][2], const Unit& u, int wr, int wc, int fr, int fq) const {
        const int rl = wr * 64 + fr;
        unsigned eoff = (unsigned)(rl * 1024 + wc * 32 + 4 * fq) * 2u, soff = (unsigned)(rl * 16 + wc) * 4u;
        asm volatile("" : "+v"(eoff), "+v"(soff));
        char* xbase = (char*)(xb + (size_t)u.pm * BM * 1024 + (size_t)u.pn * BM);
        char* sbase = (char*)ss + (size_t)u.pm * BM * 64 + u.pn * 16;
#pragma unroll
        for (int ai = 0; ai < 2; ++ai)
#pragma unroll
            for (int m = 0; m < 4; ++m) { const int ro = ai * HALF + m * 16; float q = 0.f; u32x2 b[2][2];
#pragma unroll
                for (int bj = 0; bj < 2; ++bj)
#pragma unroll
                    for (int n = 0; n < 2; ++n) b[bj][n] = *(const u32x2*)(xbase + eoff + (ro * 1024 + bj * HALF + n * 16) * 2);
#pragma unroll
                for (int bj = 0; bj < 2; ++bj)
#pragma unroll
                    for (int n = 0; n < 2; ++n) { const u32x2 bw = b[bj][n];
                        const f32x4 bb = (f32x4){__uint_as_float(bw.x << 16), __uint_as_float(bw.x & 0xffff0000u), __uint_as_float(bw.y << 16), __uint_as_float(bw.y & 0xffff0000u)};
                        const f32x4 o = bb + acc[ai][bj][m][n];
                        u32x2 w; w.x = cvtpk(o[0], o[1]); w.y = cvtpk(o[2], o[3]); *(u32x2*)(xbase + eoff + (ro * 1024 + bj * HALF + n * 16) * 2) = w;
                        q += (o[0] * o[0] + o[1] * o[1]) + (o[2] * o[2] + o[3] * o[3]); }
                q += __shfl_xor(q, 16); q += __shfl_xor(q, 32);
                if (fq == 0) *(float*)(sbase + soff + ro * 64) = q; }
    }
};
template <class Epi, class Sched, bool ALIGN_EPI = false, bool SP2 = false>
__device__ __forceinline__ void gemm_phase(PG8_LAS unsigned char* lds, const Gemm g, const Sched& S, const Epi& E) {
    int tid_ = threadIdx.x; asm volatile("" : "+v"(tid_));
    const int tid = tid_, wid = __builtin_amdgcn_readfirstlane(tid >> 6), lane = tid & 63, wr = wid >> 2, wc = wid & 3, fr = lane & 15, fq = lane >> 4;
    const int K = g.K, nt = K / BK;
    unsigned voffA[2], voffB[2];
#pragma unroll
    for (int i = 0; i < 2; ++i) { int R, C; stage_rc(tid * 16 + i * 8192, R, C); const int Rb = Epi::PERM ? ((R & ~31) + perm32(R & 31)) : R;
        voffA[i] = (unsigned)(R * K + C) * 2u; voffB[i] = (unsigned)(Rb * K + C) * 2u; }
    const size_t kstep = (size_t)(BK * 2);
    const size_t hstep = (size_t)HALF * K * 2;
    const size_t tstep = 2 * hstep;
    const unsigned ldsw = (unsigned)wid * 1024u;
    const int aoff = lds_byte(wr * 64 + fr, fq * 8), boff = lds_byte(wc * 32 + fr, fq * 8);
#define PG8_SA(b, h) (((b) * 2 + (h)) * HTB)
#define PG8_SB(b, h) ((4 + (b) * 2 + (h)) * HTB)
#define PG8_STAGE(bufoff, gbase, voff) do { _Pragma("unroll") for (int _i = 0; _i < 2; ++_i) \
        __builtin_amdgcn_global_load_lds((const unsigned*)((const char*)(gbase) + (voff)[_i]), (PG8_LAS unsigned*)(lds + (bufoff) + ldsw + _i * 8192), 16, 0, 0); } while (0)
#define PG8_LDA(dst, b, h) do { _Pragma("unroll") for (int m = 0; m < 4; ++m) _Pragma("unroll") for (int k = 0; k < 2; ++k) dst[m][k] = *(const PG8_LAS bf16x8*)(lds + PG8_SA(b, h) + aoff + m * 2048 + k * 1024); } while (0)
#define PG8_LDB(dst, b, h) do { _Pragma("unroll") for (int n = 0; n < 2; ++n) _Pragma("unroll") for (int k = 0; k < 2; ++k) dst[n][k] = *(const PG8_LAS bf16x8*)(lds + PG8_SB(b, h) + boff + n * 2048 + k * 1024); } while (0)
#define PG8_MMA(ai, bj, At, Bt) do { __builtin_amdgcn_s_setprio(1); _Pragma("unroll") for (int m = 0; m < 4; ++m) _Pragma("unroll") for (int n = 0; n < 2; ++n) _Pragma("unroll") for (int k = 0; k < 2; ++k) \
        acc[ai][bj][m][n] = __builtin_amdgcn_mfma_f32_16x16x32_bf16(Bt[n][k], At[m][k], acc[ai][bj][m][n], 0, 0, 0); __builtin_amdgcn_s_setprio(0); } while (0)
#define PG8_WAIT_V(n) asm volatile("s_waitcnt vmcnt(" #n ")" ::: "memory")
#define PG8_WAIT_L(n) asm volatile("s_waitcnt lgkmcnt(" #n ")" ::: "memory")
#define PG8_BAR __builtin_amdgcn_s_barrier()
#define PG8_SCHED __builtin_amdgcn_sched_barrier(0)
    Unit cur, nxt; int ui = 0;
    if (!S.next(0, cur)) return;
    f32x4 acc[2][2][4][2];
#pragma unroll
    for (int a = 0; a < 2; ++a)
#pragma unroll
        for (int b = 0; b < 2; ++b)
#pragma unroll
            for (int m = 0; m < 4; ++m)
#pragma unroll
                for (int n = 0; n < 2; ++n) acc[a][b][m][n] = (f32x4){0.f, 0.f, 0.f, 0.f};
    bf16x8 At[4][2], B0[2][2], B1[2][2];
    const char* cA = (const char*)g.A + (size_t)cur.pm * tstep; const char* cB = (const char*)g.Bt + (size_t)cur.pn * tstep;
    S.a_ready(cur);
    if constexpr (SP2) {
        PG8_STAGE(PG8_SB(0, 0), cB, voffB); PG8_STAGE(PG8_SB(0, 1), cB + hstep, voffB); PG8_STAGE(PG8_SA(0, 0), cA, voffA); PG8_STAGE(PG8_SA(0, 1), cA + hstep, voffA);
        if (wr == 1) PG8_BAR;
        PG8_WAIT_V(2); PG8_BAR;
        PG8_STAGE(PG8_SB(1, 0), cB + kstep, voffB); PG8_STAGE(PG8_SA(1, 0), cA + kstep, voffA); PG8_STAGE(PG8_SB(1, 1), cB + hstep + kstep, voffB);
        PG8_WAIT_V(6); PG8_BAR;
    } else {
        PG8_STAGE(PG8_SB(0, 0), cB, voffB); PG8_STAGE(PG8_SA(0, 0), cA, voffA); PG8_STAGE(PG8_SB(0, 1), cB + hstep, voffB); PG8_STAGE(PG8_SA(0, 1), cA + hstep, voffA);
        if (wr == 1) PG8_BAR;
        PG8_WAIT_V(4); PG8_BAR;
        PG8_STAGE(PG8_SB(1, 0), cB + kstep, voffB); PG8_STAGE(PG8_SA(1, 0), cA + kstep, voffA); PG8_STAGE(PG8_SB(1, 1), cB + hstep + kstep, voffB);
        PG8_WAIT_V(6); PG8_BAR;
    }
    for (;;) {
        const bool has_next = S.next(ui + 1, nxt);
        const char* nA = has_next ? (const char*)g.A + (size_t)nxt.pm * tstep : cA; const char* nB = has_next ? (const char*)g.Bt + (size_t)nxt.pn * tstep : cB;
        for (int t = 0; t < nt; t += 2) {
            const bool last = (t == nt - 2);
            const char* a1 = cA + (size_t)(t + 1) * kstep;
            const char* a2 = last ? nA : cA + (size_t)(t + 2) * kstep; const char* b2 = last ? nB : cB + (size_t)(t + 2) * kstep;
            const char* a3 = a2 + kstep; const char* b3 = b2 + kstep;
            if (last && has_next) S.a_ready(nxt);
            if constexpr (SP2) {
            PG8_LDB(B0, 0, 0); PG8_LDB(B1, 0, 1); PG8_SCHED; PG8_LDA(At, 0, 0); PG8_STAGE(PG8_SA(1, 1), a1 + hstep, voffA);
            PG8_WAIT_V(8); PG8_WAIT_L(0); PG8_BAR; PG8_MMA(0, 0, At, B0); PG8_MMA(0, 1, At, B1); PG8_BAR; PG8_SCHED;
            PG8_LDA(At, 0, 1); PG8_STAGE(PG8_SB(0, 0), b2, voffB); PG8_STAGE(PG8_SB(0, 1), b2 + hstep, voffB); PG8_STAGE(PG8_SA(0, 0), a2, voffA);
            PG8_WAIT_V(8); PG8_WAIT_L(0); PG8_BAR; PG8_MMA(1, 0, At, B0); PG8_MMA(1, 1, At, B1); PG8_BAR; PG8_SCHED;
            PG8_LDB(B0, 1, 0); PG8_LDB(B1, 1, 1); PG8_SCHED; PG8_LDA(At, 1, 0); PG8_STAGE(PG8_SA(0, 1), a2 + hstep, voffA);
            PG8_WAIT_V(8); PG8_WAIT_L(0); PG8_BAR; PG8_MMA(0, 0, At, B0); PG8_MMA(0, 1, At, B1); PG8_BAR; PG8_SCHED;
            PG8_LDA(At, 1, 1); PG8_STAGE(PG8_SB(1, 0), b3, voffB); PG8_STAGE(PG8_SB(1, 1), b3 + hstep, voffB); PG8_STAGE(PG8_SA(1, 0), a3, voffA);
            PG8_WAIT_V(8); PG8_WAIT_L(0); PG8_BAR; PG8_MMA(1, 0, At, B0); PG8_MMA(1, 1, At, B1); PG8_BAR; PG8_SCHED;
            } else {
            PG8_LDB(B0, 0, 0); PG8_SCHED; PG8_LDA(At, 0, 0); PG8_STAGE(PG8_SA(1, 1), a1 + hstep, voffA);
            PG8_WAIT_L(8); PG8_BAR; PG8_WAIT_L(0); PG8_MMA(0, 0, At, B0); PG8_BAR; PG8_SCHED;
            PG8_LDB(B1, 0, 1); PG8_STAGE(PG8_SB(0, 0), b2, voffB);
            PG8_BAR; PG8_WAIT_L(0); PG8_MMA(0, 1, At, B1); PG8_BAR;
            PG8_LDA(At, 0, 1); PG8_STAGE(PG8_SA(0, 0), a2, voffA);
            PG8_BAR; PG8_WAIT_L(0); PG8_MMA(1, 0, At, B0); PG8_BAR; PG8_SCHED;
            PG8_STAGE(PG8_SB(0, 1), b2 + hstep, voffB);
            PG8_WAIT_V(6); PG8_BAR; PG8_MMA(1, 1, At, B1); PG8_BAR;
            PG8_LDB(B0, 1, 0); PG8_SCHED; PG8_LDA(At, 1, 0); PG8_STAGE(PG8_SA(0, 1), a2 + hstep, voffA);
            PG8_WAIT_L(8); PG8_BAR; PG8_WAIT_L(0); PG8_MMA(0, 0, At, B0); PG8_BAR; PG8_SCHED;
            PG8_LDB(B1, 1, 1); PG8_STAGE(PG8_SB(1, 0), b3, voffB);
            PG8_BAR; PG8_WAIT_L(0); PG8_MMA(0, 1, At, B1); PG8_BAR;
            PG8_LDA(At, 1, 1); PG8_STAGE(PG8_SA(1, 0), a3, voffA);
            PG8_BAR; PG8_WAIT_L(0); PG8_MMA(1, 0, At, B0); PG8_BAR; PG8_SCHED;
            PG8_STAGE(PG8_SB(1, 1), b3 + hstep, voffB);
            PG8_WAIT_V(6); PG8_BAR; PG8_MMA(1, 1, At, B1); PG8_BAR;
            }
        }
        if constexpr (ALIGN_EPI) { if (wr == 0) PG8_BAR; }
        if constexpr (!Epi::AFTER_DRAIN) { E(acc, cur, wr, wc, fr, fq); S.done(cur); }
        if (!has_next) break;
#pragma unroll
        for (int a = 0; a < 2; ++a)
#pragma unroll
            for (int b = 0; b < 2; ++b)
#pragma unroll
                for (int m = 0; m < 4; ++m)
#pragma unroll
                    for (int n = 0; n < 2; ++n) acc[a][b][m][n] = (f32x4){0.f, 0.f, 0.f, 0.f};
        cur = nxt; cA = nA; cB = nB; ++ui;
        if constexpr (ALIGN_EPI) { if (wr == 1) PG8_BAR; }
    }
    PG8_WAIT_V(0);
    if constexpr (!ALIGN_EPI) { if (wr == 0) PG8_BAR; }
    PG8_BAR;
    if constexpr (Epi::AFTER_DRAIN) { E.fused(acc, cur, wr, wc, fr, fq, lds, wid, lane); S.done(cur); }
#undef PG8_SA
#undef PG8_SB
#undef PG8_STAGE
#undef PG8_LDA
#undef PG8_LDB
#undef PG8_MMA
#undef PG8_WAIT_V
#undef PG8_WAIT_L
#undef PG8_BAR
#undef PG8_SCHED
}
}

constexpr int BATCH = 2, SEQ = 16384, DM = 1024, DEPTH = 4, M_TOK = BATCH * SEQ;
constexpr int PW = 2816;
constexpr int COL_K = 512, COL_V = 1024, COL_BG = 1536, COL_CG = 1792, COL_XH = 2048, COL_SU = 2304, COL_SV = 2560;
constexpr int DFF = 4096, NCHUNK = SEQ / 64;
constexpr float LOG2E = 1.4426950408889634f;
constexpr float QSCALE = 0.125f * LOG2E;
constexpr float EPS = 1e-6f;

#define LAS __attribute__((address_space(3)))
typedef unsigned short bf16;
typedef short bf16x8 __attribute__((ext_vector_type(8)));
typedef short s16x4 __attribute__((ext_vector_type(4)));
typedef float f32x4 __attribute__((ext_vector_type(4)));
typedef float f32x2 __attribute__((ext_vector_type(2)));
typedef unsigned u32x4 __attribute__((ext_vector_type(4)));
typedef unsigned u32x2 __attribute__((ext_vector_type(2)));
using pg8::cvtpk;

__device__ __forceinline__ float bf_lo(unsigned w) { return __uint_as_float(w << 16); }
__device__ __forceinline__ float bf_hi(unsigned w) { return __uint_as_float(w & 0xffff0000u); }
__device__ __forceinline__ s16x4 tr_read(const LAS unsigned char* p) { return __builtin_bit_cast(s16x4, __builtin_amdgcn_ds_read_tr16_b64_v4i16((LAS s16x4*)p)); }
__device__ __forceinline__ bf16x8 cat8(s16x4 lo, s16x4 hi) { return __builtin_shufflevector(lo, hi, 0, 1, 2, 3, 4, 5, 6, 7); }
#define MFMA16(a, b, c) __builtin_amdgcn_mfma_f32_16x16x32_bf16((a), (b), (c), 0, 0, 0)

constexpr int VP = 144;
constexpr int ATT_WAVE_LDS = 64 * VP + 1040;
__device__ __forceinline__ void att_load_k(bf16x8 (&k)[4][2], const bf16* kb, int fr, int fq) {
#pragma unroll
    for (int kt = 0; kt < 4; ++kt)
#pragma unroll
        for (int ks = 0; ks < 2; ++ks) k[kt][ks] = *(const bf16x8*)(kb + (size_t)(kt * 16 + fr) * PW + ks * 32 + fq * 8);
}
__device__ __forceinline__ void att_load_v(u32x4 (&v)[8], const bf16* vb, int lane) {
#pragma unroll
    for (int i = 0; i < 8; ++i) v[i] = *(const u32x4*)(vb + (size_t)(i * 8 + (lane >> 3)) * PW + (lane & 7) * 8);
}
__device__ __forceinline__ void att_store_v(LAS unsigned char* Vl, const u32x4 (&v)[8], int lane) {
#pragma unroll
    for (int i = 0; i < 8; ++i) *(LAS u32x4*)(Vl + (i * 8 + (lane >> 3)) * VP + (lane & 7) * 16) = v[i];
}
__device__ __forceinline__ void attn_item(const bf16* proj, bf16* mixed, const float* relb, int b, int c, int hg, LAS unsigned char* lds, int wid, int lane) {
    const int h = hg * 4 + (wid >> 1), qh = wid & 1, fr = lane & 15, fq = lane >> 4;
    LAS unsigned char* Vl = lds + wid * ATT_WAVE_LDS;
    LAS float* tb = (LAS float*)(Vl + 64 * VP);
    const size_t tokq = (size_t)b * SEQ + (size_t)c * 64 + qh * 32;
    bf16x8 qf[2][2];
#pragma unroll
    for (int qt = 0; qt < 2; ++qt)
#pragma unroll
        for (int ks = 0; ks < 2; ++ks) qf[qt][ks] = *(const bf16x8*)(proj + (tokq + qt * 16 + fr) * PW + h * 64 + ks * 32 + fq * 8);
    for (int i = lane; i < 257; i += 64) tb[i] = relb[h * 257 + i] * LOG2E;
    float mrun[2] = {-1e30f, -1e30f}, lrun[2] = {0.f, 0.f};
    f32x4 o[4][2];
#pragma unroll
    for (int dt = 0; dt < 4; ++dt)
#pragma unroll
        for (int qt = 0; qt < 2; ++qt) o[dt][qt] = (f32x4){0.f, 0.f, 0.f, 0.f};
    const int j0 = (c < 8) ? 8 - c : 0;
    const bf16* kbase = proj + ((size_t)b * SEQ) * PW + COL_K + h * 64;
    bf16x8 kf[4][2]; u32x4 vn[8];
    { const bf16* kb = kbase + (size_t)(c - 8 + j0) * 64 * PW; att_load_k(kf, kb, fr, fq); att_load_v(vn, kb + (COL_V - COL_K), lane); }
    att_store_v(Vl, vn, lane);
    asm volatile("" ::: "memory");
    const int iq0 = qh * 32 + fr;
    for (int j = j0; j <= 8; ++j) {
        bf16x8 kn[4][2];
        { const int jn = (j < 8) ? j + 1 : 8; const bf16* kb = kbase + (size_t)(c - 8 + jn) * 64 * PW; att_load_k(kn, kb, fr, fq); att_load_v(vn, kb + (COL_V - COL_K), lane); }
        f32x4 s[4][2];
#pragma unroll
        for (int kt = 0; kt < 4; ++kt)
#pragma unroll
            for (int qt = 0; qt < 2; ++qt) { f32x4 a = (f32x4){0.f, 0.f, 0.f, 0.f}; a = MFMA16(kf[kt][0], qf[qt][0], a); a = MFMA16(kf[kt][1], qf[qt][1], a); s[kt][qt] = a; }
        if (j <= 5) { const float bc = tb[256];
#pragma unroll
            for (int kt = 0; kt < 4; ++kt)
#pragma unroll
                for (int qt = 0; qt < 2; ++qt) s[kt][qt] = s[kt][qt] + bc;
        } else { const int cb = 512 - 64 * j;
#pragma unroll
            for (int kt = 0; kt < 4; ++kt)
#pragma unroll
                for (int qt = 0; qt < 2; ++qt)
#pragma unroll
                    for (int r = 0; r < 4; ++r) { int rel = (iq0 + qt * 16) - (kt * 16 + 4 * fq + r) + cb; rel = rel < -128 ? -128 : (rel > 128 ? 128 : rel); s[kt][qt][r] += tb[rel + 128]; }
        }
        bf16x8 pf[2][2];
#pragma unroll
        for (int qt = 0; qt < 2; ++qt) {
            float mx = s[0][qt][0];
#pragma unroll
            for (int kt = 0; kt < 4; ++kt)
#pragma unroll
                for (int r = 0; r < 4; ++r) mx = fmaxf(mx, s[kt][qt][r]);
            mx = fmaxf(mx, __shfl_xor(mx, 16)); mx = fmaxf(mx, __shfl_xor(mx, 32));
            const float mn = fmaxf(mrun[qt], mx), al = __builtin_amdgcn_exp2f(mrun[qt] - mn); mrun[qt] = mn;
            float ps = 0.f;
#pragma unroll
            for (int kt = 0; kt < 4; ++kt)
#pragma unroll
                for (int r = 0; r < 4; ++r) { const float p = __builtin_amdgcn_exp2f(s[kt][qt][r] - mn); s[kt][qt][r] = p; ps += p; }
            lrun[qt] = lrun[qt] * al + ps;
#pragma unroll
            for (int dt = 0; dt < 4; ++dt) o[dt][qt] = o[dt][qt] * al;
#pragma unroll
            for (int s2 = 0; s2 < 2; ++s2) { u32x4 w; w.x = cvtpk(s[2 * s2][qt][0], s[2 * s2][qt][1]); w.y = cvtpk(s[2 * s2][qt][2], s[2 * s2][qt][3]);
                w.z = cvtpk(s[2 * s2 + 1][qt][0], s[2 * s2 + 1][qt][1]); w.w = cvtpk(s[2 * s2 + 1][qt][2], s[2 * s2 + 1][qt][3]); pf[qt][s2] = __builtin_bit_cast(bf16x8, w); }
        }
        const LAS unsigned char* vrd = Vl + (4 * fq + (fr >> 2)) * VP + (lane & 3) * 8;
#pragma unroll
        for (int s2 = 0; s2 < 2; ++s2)
#pragma unroll
            for (int dt = 0; dt < 4; ++dt) {
                const s16x4 lo = tr_read(vrd + (32 * s2) * VP + dt * 32), hi = tr_read(vrd + (32 * s2 + 16) * VP + dt * 32);
                const bf16x8 vf = cat8(lo, hi);
#pragma unroll
                for (int qt = 0; qt < 2; ++qt) o[dt][qt] = MFMA16(vf, pf[qt][s2], o[dt][qt]);
            }
        asm volatile("" ::: "memory");
        att_store_v(Vl, vn, lane);
        asm volatile("" ::: "memory");
#pragma unroll
        for (int kt = 0; kt < 4; ++kt)
#pragma unroll
            for (int ks = 0; ks < 2; ++ks) kf[kt][ks] = kn[kt][ks];
    }
#pragma unroll
    for (int qt = 0; qt < 2; ++qt) {
        float l = lrun[qt]; l += __shfl_xor(l, 16); l += __shfl_xor(l, 32);
        const float inv = 1.0f / l; float q = 0.f;
#pragma unroll
        for (int dt = 0; dt < 4; ++dt) { o[dt][qt] = o[dt][qt] * inv; const f32x4 v = o[dt][qt]; q += (v[0] * v[0] + v[1] * v[1]) + (v[2] * v[2] + v[3] * v[3]); }
        q += __shfl_xor(q, 16); q += __shfl_xor(q, 32);
        const float rs = __builtin_amdgcn_rsqf(q * (1.0f / 64.0f) + EPS);
        bf16* op = mixed + (tokq + qt * 16 + fr) * DM + h * 64 + 4 * fq;
#pragma unroll
        for (int dt = 0; dt < 4; ++dt) { const f32x4 v = o[dt][qt] * rs; u32x2 w; w.x = cvtpk(v[0], v[1]); w.y = cvtpk(v[2], v[3]); *(u32x2*)(op + dt * 16) = w; }
    }
}

constexpr int ATT_SLOT = 16384, ATT_TB_OFF = 4 * ATT_SLOT;
__device__ __forceinline__ int att_swz(int row) { return (((row >> 1) & 3) << 1) | ((row >> 3) & 1); }
__device__ __forceinline__ void attn_unit2(const bf16* proj, bf16* mixed, const float* relb, int b, int h, int cq, LAS unsigned char* lds, int tid, int wid, int lane) {
    const int fr = lane & 15, fq = lane >> 4, ci = wid >> 1, qh = wid & 1;
    const size_t tokq = (size_t)b * SEQ + (size_t)(cq * 4 + ci) * 64 + qh * 32;
    LAS float* tb = (LAS float*)(lds + ATT_TB_OFF);
    for (int i = tid; i < 320; i += 512) tb[i] = relb[h * 257 + (i < 256 ? i : 256)] * LOG2E;
    bf16x8 qf[2][2];
#pragma unroll
    for (int qt = 0; qt < 2; ++qt)
#pragma unroll
        for (int ks = 0; ks < 2; ++ks) qf[qt][ks] = *(const bf16x8*)(proj + (tokq + qt * 16 + fr) * PW + h * 64 + ks * 32 + fq * 8);
    asm volatile("s_waitcnt vmcnt(0) lgkmcnt(0)" ::: "memory");
    const int srow = 8 * wid + (lane >> 3), sch = (lane & 7) ^ att_swz(srow);
    const bf16* ksrc = proj + ((long)b * SEQ + (long)(4 * cq - 8) * 64 + srow) * PW + COL_K + h * 64 + sch * 8;
    const unsigned ldsw = (unsigned)wid * 1024u;
#define ATT_DMA(t_) do { const int tt_ = (t_) > 11 ? 11 : (t_); const int sl_ = (tt_ & 3) * ATT_SLOT; const bf16* g_ = ksrc + (long)tt_ * 64 * PW; \
        __builtin_amdgcn_global_load_lds((const unsigned*)g_, (LAS unsigned*)(lds + sl_ + ldsw), 16, 0, 0); \
        __builtin_amdgcn_global_load_lds((const unsigned*)(g_ + (COL_V - COL_K)), (LAS unsigned*)(lds + sl_ + 8192 + ldsw), 16, 0, 0); } while (0)
    const int t0 = (cq < 2) ? 8 - 4 * cq : 0;
    ATT_DMA(t0); ATT_DMA(t0 + 1); ATT_DMA(t0 + 2);
    float mref[2] = {0.f, 0.f};
    f32x4 o[4][2], lacc[2];
#pragma unroll
    for (int qt = 0; qt < 2; ++qt) { lacc[qt] = (f32x4){0.f, 0.f, 0.f, 0.f};
#pragma unroll
        for (int dt = 0; dt < 4; ++dt) o[dt][qt] = (f32x4){0.f, 0.f, 0.f, 0.f}; }
    const bf16x8 ones = (bf16x8){0x3F80, 0x3F80, 0x3F80, 0x3F80, 0x3F80, 0x3F80, 0x3F80, 0x3F80};
    const int iq0 = qh * 32 + fr;
    const int koff = fr * 128, kswz = att_swz(fr);
    const int vrow = 4 * fq + (fr >> 2), vswz = att_swz(vrow), voff = vrow * 128 + 8 * (fr & 1), vch = (fr & 3) >> 1;
    const int tfirst = t0 > ci ? t0 : ci;
#pragma unroll 1
    for (int t = t0; t < 12; ++t) {
        asm volatile("s_waitcnt vmcnt(4)" ::: "memory");
        __builtin_amdgcn_s_barrier();
        asm volatile("" ::: "memory");
        ATT_DMA(t + 3);
        const int j = t - ci;
        if (j >= 0 && j <= 8) {
            const LAS unsigned char* Ks = lds + (t & 3) * ATT_SLOT; const LAS unsigned char* Vs = Ks + 8192;
            const float bc = (j <= 5) ? tb[256] : 0.f;
            f32x4 cini[2];
#pragma unroll
            for (int qt = 0; qt < 2; ++qt) { const float c0 = bc - mref[qt]; cini[qt] = (f32x4){c0, c0, c0, c0}; }
            f32x4 s[4][2];
#pragma unroll
            for (int kt = 0; kt < 4; ++kt) {
                const bf16x8 k0 = *(const LAS bf16x8*)(Ks + kt * 2048 + koff + (((0 + fq) ^ kswz) << 4)), k1 = *(const LAS bf16x8*)(Ks + kt * 2048 + koff + (((4 + fq) ^ kswz) << 4));
#pragma unroll
                for (int qt = 0; qt < 2; ++qt) { f32x4 a = MFMA16(k0, qf[qt][0], cini[qt]); a = MFMA16(k1, qf[qt][1], a); s[kt][qt] = a; }
            }
            if (j > 5) { const LAS float* tl = tb + (iq0 - 4 * fq + (512 - 64 * j) + 128 - 51);
#pragma unroll
                for (int kt = 0; kt < 4; ++kt)
#pragma unroll
                    for (int qt = 0; qt < 2; ++qt)
#pragma unroll
                        for (int r = 0; r < 4; ++r) s[kt][qt][r] += tl[16 * qt - 16 * kt - r + 51];
            }
            float mx[2];
#pragma unroll
            for (int qt = 0; qt < 2; ++qt) { float m = s[0][qt][0];
#pragma unroll
                for (int kt = 0; kt < 4; ++kt)
#pragma unroll
                    for (int r = 0; r < 4; ++r) m = fmaxf(m, s[kt][qt][r]);
                m = fmaxf(m, __shfl_xor(m, 16)); m = fmaxf(m, __shfl_xor(m, 32)); mx[qt] = m; }
            const bool first = (t == tfirst);
            if (first || __any(fmaxf(mx[0], mx[1]) > 8.0f)) {
#pragma unroll
                for (int qt = 0; qt < 2; ++qt) { const float dl = first ? mx[qt] : fmaxf(mx[qt], 0.f); mref[qt] += dl; const float al = __builtin_amdgcn_exp2f(-dl);
                    lacc[qt] = lacc[qt] * al;
#pragma unroll
                    for (int dt = 0; dt < 4; ++dt) o[dt][qt] = o[dt][qt] * al;
#pragma unroll
                    for (int kt = 0; kt < 4; ++kt) s[kt][qt] = s[kt][qt] - dl; }
            }
            bf16x8 pf[2][2];
#pragma unroll
            for (int qt = 0; qt < 2; ++qt) {
#pragma unroll
                for (int kt = 0; kt < 4; ++kt)
#pragma unroll
                    for (int r = 0; r < 4; ++r) s[kt][qt][r] = __builtin_amdgcn_exp2f(s[kt][qt][r]);
#pragma unroll
                for (int s2 = 0; s2 < 2; ++s2) { u32x4 w; w.x = cvtpk(s[2 * s2][qt][0], s[2 * s2][qt][1]); w.y = cvtpk(s[2 * s2][qt][2], s[2 * s2][qt][3]);
                    w.z = cvtpk(s[2 * s2 + 1][qt][0], s[2 * s2 + 1][qt][1]); w.w = cvtpk(s[2 * s2 + 1][qt][2], s[2 * s2 + 1][qt][3]); pf[qt][s2] = __builtin_bit_cast(bf16x8, w);
                    lacc[qt] = MFMA16(ones, pf[qt][s2], lacc[qt]); }
            }
#pragma unroll
            for (int s2 = 0; s2 < 2; ++s2) {
                s16x4 lo[4], hi[4];
#pragma unroll
                for (int dt = 0; dt < 4; ++dt) { const unsigned va = (unsigned)(uintptr_t)(Vs + voff) + (unsigned)(((2 * dt + vch) ^ vswz) << 4);
                    asm volatile("ds_read_b64_tr_b16 %0, %1 offset:%c2" : "=&v"(lo[dt]) : "v"(va), "i"((32 * s2) * 128) : "memory");
                    asm volatile("ds_read_b64_tr_b16 %0, %1 offset:%c2" : "=&v"(hi[dt]) : "v"(va), "i"((32 * s2 + 16) * 128) : "memory"); }
                asm volatile("s_waitcnt lgkmcnt(0)" : "+v"(lo[0]), "+v"(hi[0]), "+v"(lo[1]), "+v"(hi[1]), "+v"(lo[2]), "+v"(hi[2]), "+v"(lo[3]), "+v"(hi[3]) :: "memory");
#pragma unroll
                for (int dt = 0; dt < 4; ++dt) { const bf16x8 vf = cat8(lo[dt], hi[dt]);
#pragma unroll
                    for (int qt = 0; qt < 2; ++qt) o[dt][qt] = MFMA16(vf, pf[qt][s2], o[dt][qt]); }
            }
        }
    }
#undef ATT_DMA
#pragma unroll
    for (int qt = 0; qt < 2; ++qt) {
        const float inv = 1.0f / lacc[qt][0]; float q = 0.f;
#pragma unroll
        for (int dt = 0; dt < 4; ++dt) { o[dt][qt] = o[dt][qt] * inv; const f32x4 v = o[dt][qt]; q += (v[0] * v[0] + v[1] * v[1]) + (v[2] * v[2] + v[3] * v[3]); }
        q += __shfl_xor(q, 16); q += __shfl_xor(q, 32);
        const float rs = __builtin_amdgcn_rsqf(q * (1.0f / 64.0f) + EPS);
        bf16* op = mixed + (tokq + qt * 16 + fr) * DM + h * 64 + 4 * fq;
#pragma unroll
        for (int dt = 0; dt < 4; ++dt) { const f32x4 v = o[dt][qt] * rs; u32x2 w; w.x = cvtpk(v[0], v[1]); w.y = cvtpk(v[2], v[3]); *(u32x2*)(op + dt * 16) = w; }
    }
    asm volatile("s_waitcnt vmcnt(0) lgkmcnt(0)" ::: "memory"); __builtin_amdgcn_s_barrier(); asm volatile("" ::: "memory");
}

__device__ __forceinline__ void unpack8(float (&f)[8], u32x4 w) { f[0] = bf_lo(w.x); f[1] = bf_hi(w.x); f[2] = bf_lo(w.y); f[3] = bf_hi(w.y); f[4] = bf_lo(w.z); f[5] = bf_hi(w.z); f[6] = bf_lo(w.w); f[7] = bf_hi(w.w); }
__device__ __forceinline__ void conv_item(const bf16* proj, bf16* mixed, const float* cw, int item, int tid) {
    const int oc = tid & 31, c0 = oc * 8;
    u32x4 rb[4], ra[4][3], rx[4][3];
#pragma unroll
    for (int p = 0; p < 4; ++p) { const int t = item * 64 + p * 16 + (tid >> 5), ts = t & (SEQ - 1); const bf16* rp = proj + (size_t)t * PW + c0;
        rb[p] = *(const u32x4*)(rp + COL_BG);
#pragma unroll
        for (int k = 0; k < 3; ++k) { const bf16* rk = rp - (size_t)((ts >= k) ? k : 0) * PW; ra[p][k] = *(const u32x4*)(rk + COL_CG); rx[p][k] = *(const u32x4*)(rk + COL_XH); } }
    float w0[8], w1[8], w2[8];
#pragma unroll
    for (int i = 0; i < 8; ++i) { w0[i] = cw[c0 + i]; w1[i] = cw[256 + c0 + i]; w2[i] = cw[512 + c0 + i]; }
#pragma unroll
    for (int p = 0; p < 4; ++p) { const int t = item * 64 + p * 16 + (tid >> 5), ts = t & (SEQ - 1);
        const float m1 = (ts >= 1) ? 1.f : 0.f, m2 = (ts >= 2) ? 1.f : 0.f;
        float bg[8], a[8], x[8], y[8], z[8];
        unpack8(bg, rb[p]);
        unpack8(a, ra[p][0]); unpack8(x, rx[p][0]);
#pragma unroll
        for (int i = 0; i < 8; ++i) y[i] = w2[i] * (a[i] * x[i]);
        unpack8(a, ra[p][1]); unpack8(x, rx[p][1]);
#pragma unroll
        for (int i = 0; i < 8; ++i) y[i] += (w1[i] * m1) * (a[i] * x[i]);
        unpack8(a, ra[p][2]); unpack8(x, rx[p][2]);
#pragma unroll
        for (int i = 0; i < 8; ++i) y[i] += (w0[i] * m2) * (a[i] * x[i]);
        float q = 0.f;
#pragma unroll
        for (int i = 0; i < 8; ++i) { z[i] = bg[i] * y[i]; q += z[i] * z[i]; }
        q += __shfl_xor(q, 1); q += __shfl_xor(q, 2); q += __shfl_xor(q, 4);
        const float rs = __builtin_amdgcn_rsqf(q * (1.0f / 64.0f) + EPS);
        u32x4 w; w.x = cvtpk(z[0] * rs, z[1] * rs); w.y = cvtpk(z[2] * rs, z[3] * rs); w.z = cvtpk(z[4] * rs, z[5] * rs); w.w = cvtpk(z[6] * rs, z[7] * rs);
        *(u32x4*)(mixed + (size_t)t * DM + 512 + c0) = w;
    }
}

constexpr int GP = 544;
__device__ __forceinline__ void gate_item(const bf16* proj, bf16* mixed, const float* lng, const float* lnb, const bf16* wsb, const float* sgb, int blk, LAS unsigned char* lds, int tid, int wid, int lane) {
    const size_t tok0 = (size_t)blk * 128;
    const int g = wid >> 1, th = wid & 1, fr = lane & 15, fq = lane >> 4;
    { const int tk = tid >> 2, part = tid & 3;
        const bf16* rp = proj + (tok0 + tk) * PW + COL_SV + part * 64;
        u32x4 xr[8];
#pragma unroll
        for (int i = 0; i < 8; ++i) xr[i] = *(const u32x4*)(rp + i * 8);
        float sm = 0.f;
#pragma unroll
        for (int i = 0; i < 8; ++i) { float f[8]; unpack8(f, xr[i]); sm += ((f[0] + f[1]) + (f[2] + f[3])) + ((f[4] + f[5]) + (f[6] + f[7])); }
        sm += __shfl_xor(sm, 1); sm += __shfl_xor(sm, 2);
        const float mu = sm * (1.0f / 256.0f); float q = 0.f;
#pragma unroll
        for (int i = 0; i < 8; ++i) { float f[8]; unpack8(f, xr[i]);
#pragma unroll
            for (int k = 0; k < 8; ++k) { const float d = f[k] - mu; q += d * d; } }
        q += __shfl_xor(q, 1); q += __shfl_xor(q, 2);
        const float rs = __builtin_amdgcn_rsqf(q * (1.0f / 256.0f) + EPS);
        LAS unsigned char* wp = lds + tk * GP + part * 128;
#pragma unroll
        for (int i = 0; i < 8; ++i) { const f32x4 g0 = *(const f32x4*)(lng + part * 64 + i * 8), g1 = *(const f32x4*)(lng + part * 64 + i * 8 + 4), b0 = *(const f32x4*)(lnb + part * 64 + i * 8), b1 = *(const f32x4*)(lnb + part * 64 + i * 8 + 4);
            float f[8]; unpack8(f, xr[i]);
#pragma unroll
            for (int k = 0; k < 8; ++k) f[k] = (f[k] - mu) * rs;
            u32x4 w; w.x = cvtpk(f[0] * g0[0] + b0[0], f[1] * g0[1] + b0[1]); w.y = cvtpk(f[2] * g0[2] + b0[2], f[3] * g0[3] + b0[3]);
            w.z = cvtpk(f[4] * g1[0] + b1[0], f[5] * g1[1] + b1[1]); w.w = cvtpk(f[6] * g1[2] + b1[2], f[7] * g1[3] + b1[3]);
            *(LAS u32x4*)(wp + i * 16) = w; }
    }
    __syncthreads();
    {
        u32x2 uw[4][4]; float biasr[4];
        int frl = fr; asm volatile("" : "+v"(frl));
#pragma unroll
        for (int tt = 0; tt < 4; ++tt) { const int t = th * 64 + tt * 16 + frl; biasr[tt] = sgb[g * 128 + t]; const bf16* up = proj + (tok0 + t) * PW + COL_SU + g * 64 + 4 * fq;
#pragma unroll
            for (int ct = 0; ct < 4; ++ct) uw[tt][ct] = *(const u32x2*)(up + ct * 16); }
        f32x4 acc[4][4];
#pragma unroll
        for (int ct = 0; ct < 4; ++ct)
#pragma unroll
            for (int tt = 0; tt < 4; ++tt) acc[ct][tt] = (f32x4){0.f, 0.f, 0.f, 0.f};
        const int nks = th ? 4 : 2;
        const LAS unsigned char* vrd = lds + (8 * fq + (fr >> 2)) * GP + g * 128 + (lane & 3) * 8;
        const bf16* wrow = wsb + ((size_t)g * 128 + th * 64 + frl) * 128 + 8 * fq;
#pragma unroll 1
        for (int ks = 0; ks < nks; ++ks) {
            bf16x8 wf[4];
#pragma unroll
            for (int tt = 0; tt < 4; ++tt) wf[tt] = *(const bf16x8*)(wrow + (size_t)(tt * 16) * 128 + ks * 32);
            bf16x8 vf[4];
#pragma unroll
            for (int ct = 0; ct < 4; ++ct) { const s16x4 lo = tr_read(vrd + (32 * ks) * GP + ct * 32), hi = tr_read(vrd + (32 * ks + 4) * GP + ct * 32); vf[ct] = cat8(lo, hi); }
#pragma unroll
            for (int tt = 0; tt < 4; ++tt)
#pragma unroll
                for (int ct = 0; ct < 4; ++ct) acc[ct][tt] = MFMA16(vf[ct], wf[tt], acc[ct][tt]);
        }
#pragma unroll
        for (int tt = 0; tt < 4; ++tt) { const int t = th * 64 + tt * 16 + fr; const float bias = biasr[tt];
            float q = 0.f; f32x4 v[4];
#pragma unroll
            for (int ct = 0; ct < 4; ++ct) { const u32x2 uq = uw[tt][ct]; const f32x4 uu = (f32x4){bf_lo(uq.x), bf_hi(uq.x), bf_lo(uq.y), bf_hi(uq.y)};
                v[ct] = uu * (acc[ct][tt] + bias); q += (v[ct][0] * v[ct][0] + v[ct][1] * v[ct][1]) + (v[ct][2] * v[ct][2] + v[ct][3] * v[ct][3]); }
            q += __shfl_xor(q, 16); q += __shfl_xor(q, 32);
            const float rs = __builtin_amdgcn_rsqf(q * (1.0f / 64.0f) + EPS);
            bf16* op = mixed + (tok0 + t) * DM + 768 + g * 64 + 4 * fq;
#pragma unroll
            for (int ct = 0; ct < 4; ++ct) { const f32x4 r = v[ct] * rs; u32x2 w; w.x = cvtpk(r[0], r[1]); w.y = cvtpk(r[2], r[3]); *(u32x2*)(op + ct * 16) = w; }
        }
    }
    __syncthreads();
}

constexpr size_t MiB = 1u << 20;
constexpr size_t SZ_WIN = (size_t)PW * DM * 2, SZ_WOUT = (size_t)DM * DM * 2, SZ_WUP = (size_t)DFF * DM * 2, SZ_WDN = (size_t)DM * DFF * 2, SZ_WSG = (size_t)4 * 128 * 128 * 2;
constexpr size_t WS_WIN = 0;
constexpr size_t WS_WOUT = WS_WIN + DEPTH * SZ_WIN;
constexpr size_t WS_WUP = WS_WOUT + DEPTH * SZ_WOUT;
constexpr size_t WS_WDN = WS_WUP + DEPTH * SZ_WUP;
constexpr size_t WS_WSG = WS_WDN + DEPTH * SZ_WDN;
constexpr size_t WS_SS = WS_WSG + DEPTH * SZ_WSG;
constexpr size_t WS_XB = WS_SS + (size_t)M_TOK * 16 * 4;
constexpr size_t WS_PROJ = WS_XB + (size_t)M_TOK * DM * 2;
constexpr size_t WS_MIX = WS_PROJ + (size_t)M_TOK * PW * 2;
constexpr size_t WS_HDN = WS_PROJ;
constexpr size_t WS_CTL = WS_HDN + (size_t)M_TOK * DFF * 2, CTL_BYTES = 65536;
constexpr size_t WS_END = WS_CTL + CTL_BYTES;
static_assert(WS_MIX + (size_t)M_TOK * DM * 2 <= WS_CTL, "hdn covers proj + mixed");
static_assert(WS_WOUT % 256 == 0 && WS_WUP % 256 == 0 && WS_WDN % 256 == 0 && WS_WSG % 256 == 0 && WS_SS % 256 == 0 && WS_XB % 256 == 0 && WS_PROJ % 256 == 0 && WS_MIX % 256 == 0, "alignment");

constexpr int NWAVES = 8;
constexpr int LDS_BYTES = 132096;
static_assert(8 * ATT_WAVE_LDS <= 131072 && 128 * GP <= 131072, "LDS map");

#define XB_TMO      128
#define XB_XCNT(j)  (256  + 64 * (j))
#define XB_XSUB(j)  (1280 + 64 * (j))
#define XB_XGEN(j)  (2304 + 64 * (j))
#define XB_TOP      3328
#define XB_TOPGEN   3392
#define XCD_BAR_WORDS 3456
#define XB_SPIN_CAP (1u << 18)

__device__ __forceinline__ unsigned xb_ld(unsigned* p)              { return __hip_atomic_load(p, __ATOMIC_RELAXED, __HIP_MEMORY_SCOPE_AGENT); }
__device__ __forceinline__ unsigned xb_add(unsigned* p, unsigned v) { return __hip_atomic_fetch_add(p, v, __ATOMIC_RELAXED, __HIP_MEMORY_SCOPE_AGENT); }
__device__ __forceinline__ unsigned xb_xcc_id() { return (unsigned)__builtin_amdgcn_s_getreg((3 << 11) | 20) & 0xFu; }
#define XB_SPIN(cond, bar) do { unsigned _sp = 0; while (cond) { __builtin_amdgcn_s_sleep(1); \
    if ((++_sp & 255u) == 0u) { if (xb_ld(&(bar)[XB_TMO])) break; if (_sp > XB_SPIN_CAP) { atomicAdd(&(bar)[XB_TMO], 1u); break; } } } } while (0)

struct XcdBarrier {
    unsigned* bar; unsigned x;
    volatile LAS unsigned* st;
};

__device__ __forceinline__ XcdBarrier xcd_barrier_post(unsigned* bar, volatile LAS unsigned* st) {
    XcdBarrier b; b.bar = bar; b.x = xb_xcc_id(); b.st = st;
    if (threadIdx.x == 0) (void)xb_add(&bar[XB_XCNT(b.x)], 1u);
    return b;
}
__device__ __forceinline__ void xcd_barrier_complete(unsigned* bar, unsigned x, unsigned& nloc, unsigned& nx) {
    const unsigned G = gridDim.x * gridDim.y * gridDim.z;
    unsigned sum, cnt, mine, sp = 0u;
    for (;;) {
        sum = 0u; cnt = 0u; mine = 0u;
#pragma unroll
        for (unsigned j = 0; j < 16; ++j) { const unsigned c = xb_ld(&bar[XB_XCNT(j)]); sum += c; cnt += (c > 0u) ? 1u : 0u; mine = (j == x) ? c : mine; }
        if (sum == G) break;
        __builtin_amdgcn_s_sleep(1);
        if ((++sp & 255u) == 0u) { if (xb_ld(&bar[XB_TMO])) break; if (sp > XB_SPIN_CAP) { atomicAdd(&bar[XB_TMO], 1u); break; } }
    }
    nloc = mine > 0u ? mine : 1u; nx = cnt > 0u ? cnt : 1u;
}

__device__ __forceinline__ void xcd_barrier(const XcdBarrier& b) {
    asm volatile("s_waitcnt vmcnt(0)" ::: "memory");
    __syncthreads();
    if (threadIdx.x == 0) {
        unsigned* bar = b.bar;
        __builtin_amdgcn_s_waitcnt(0);
        unsigned nloc = b.st[0], nx = b.st[1];
        if (nloc == 0u) { xcd_barrier_complete(bar, b.x, nloc, nx); b.st[0] = nloc; b.st[1] = nx; }
        const unsigned old = xb_add(&bar[XB_XSUB(b.x)], 1u);
        const unsigned gen = old / nloc;
        if (old + 1u == (gen + 1u) * nloc) {
            __builtin_amdgcn_fence(__ATOMIC_RELEASE, "agent");
            asm volatile("s_waitcnt vmcnt(0)" ::: "memory");
            const unsigned og = xb_add(&bar[XB_TOP], 1u);
            const unsigned tg = og / nx;
            if (og + 1u == (tg + 1u) * nx) xb_add(&bar[XB_TOPGEN], 1u);
            else XB_SPIN(xb_ld(&bar[XB_TOPGEN]) == tg, bar);
            __builtin_amdgcn_fence(__ATOMIC_ACQUIRE, "agent");
            xb_add(&bar[XB_XGEN(b.x)], 1u);
            asm volatile("s_waitcnt vmcnt(0)" ::: "memory");
        } else {
            XB_SPIN(xb_ld(&bar[XB_XGEN(b.x)]) == gen, bar);
            __builtin_amdgcn_fence(__ATOMIC_ACQUIRE, "agent");
            asm volatile("s_waitcnt vmcnt(0)" ::: "memory");
        }
    }
    __syncthreads();
}

__device__ __forceinline__ unsigned f2bf(float f) { unsigned u = __builtin_bit_cast(unsigned, f); return (u + 0x7fffu + ((u >> 16) & 1u)) >> 16; }
__device__ __forceinline__ unsigned pk2(float lo, float hi) { return f2bf(lo) | (f2bf(hi) << 16); }
__device__ __forceinline__ float wave_sum(float v) {
#pragma unroll
    for (int o = 1; o < 64; o <<= 1) v += __shfl_xor(v, o);
    return v;
}
__device__ __forceinline__ void p0_transpose_item(const float* W, const float* gain, int K, int N, bf16* WT, LAS float* scr, int item, int lane) {
    const int nblk = N / 32, kb = item / nblk, nb = item % nblk, k0 = 64 * kb, n0 = 32 * nb;
#pragma unroll 8
    for (int i = 0; i < 32; ++i) { const int kk = 2 * i + (lane >> 5); const float gsc = gain ? gain[k0 + kk] : 1.0f; scr[kk * 33 + (lane & 31)] = W[(size_t)(k0 + kk) * N + n0 + (lane & 31)] * gsc; }
    asm volatile("s_waitcnt lgkmcnt(0)" ::: "memory");
    const int c = lane & 7;
#pragma unroll
    for (int j = 0; j < 4; ++j) { const int n = (lane >> 3) + 8 * j; const LAS float* s = scr + (8 * c) * 33 + n;
        u32x4 o; o.x = pk2(s[0 * 33], s[1 * 33]); o.y = pk2(s[2 * 33], s[3 * 33]); o.z = pk2(s[4 * 33], s[5 * 33]); o.w = pk2(s[6 * 33], s[7 * 33]);
        *(u32x4*)(WT + (size_t)(n0 + n) * K + k0 + 8 * c) = o; }
    asm volatile("s_waitcnt lgkmcnt(0)" ::: "memory");
}

struct Args { const float* in[15]; float* out; unsigned char* ws; };

__global__ void __launch_bounds__(NWAVES * 64, 2) trunk_fwd(Args args) {
    extern __shared__ __attribute__((aligned(16))) unsigned char lds_raw[];
    cg::grid_group grid = cg::this_grid();
    LAS unsigned char* lds = (LAS unsigned char*)lds_raw;
    const int G = gridDim.x, bx = blockIdx.x;
    const int vcu = (G % 8 == 0) ? (bx % 8) * (G / 8) + bx / 8 : bx;
    unsigned char* ws = args.ws;
    if (threadIdx.x < 64) ((LAS unsigned*)(lds + 131072))[threadIdx.x] = 0u;
    __syncthreads();
    const XcdBarrier bar = xcd_barrier_post((unsigned*)(ws + WS_CTL), (volatile LAS unsigned*)(lds + 131072));
    const float* x_in = args.in[0];
    float* X = args.out;
    bf16* XB = (bf16*)(ws + WS_XB); float* SS = (float*)(ws + WS_SS);
    bf16* PROJ = (bf16*)(ws + WS_PROJ); bf16* MIXB = (bf16*)(ws + WS_MIX); bf16* HDN = (bf16*)(ws + WS_HDN);

    {
        int tid = threadIdx.x; asm volatile("" : "+v"(tid)); const int lane = tid & 63, wid = __builtin_amdgcn_readfirstlane(tid >> 6);
        LAS float* scr = (LAS float*)(lds + wid * 16384);
        const int gw = vcu * NWAVES + wid, NGW = G * NWAVES;
        constexpr int I_IN = (DM / 64) * (PW / 32), I_OUT = (DM / 64) * (DM / 32), I_UP = (DM / 64) * (DFF / 32), I_DN = (DFF / 64) * (DM / 32), I_L = I_IN + I_OUT + I_UP + I_DN;
        for (int it = gw; it < DEPTH * I_L; it += NGW) {
            const int l = it / I_L; int r = it % I_L;
            if (r < I_IN) { p0_transpose_item(args.in[2] + (size_t)l * DM * PW, args.in[1] + l * DM, DM, PW, (bf16*)(ws + WS_WIN + l * SZ_WIN), scr, r, lane); continue; } r -= I_IN;
            if (r < I_OUT) { p0_transpose_item(args.in[10] + (size_t)l * DM * DM, args.in[9] + l * DM, DM, DM, (bf16*)(ws + WS_WOUT + l * SZ_WOUT), scr, r, lane); continue; } r -= I_OUT;
            if (r < I_UP) { p0_transpose_item(args.in[12] + (size_t)l * DM * DFF, args.in[11] + l * DM, DM, DFF, (bf16*)(ws + WS_WUP + l * SZ_WUP), scr, r, lane); continue; } r -= I_UP;
            p0_transpose_item(args.in[13] + (size_t)l * DFF * DM, nullptr, DFF, DM, (bf16*)(ws + WS_WDN + l * SZ_WDN), scr, r, lane);
        }
        { const float* sw = args.in[7]; bf16* wsg = (bf16*)(ws + WS_WSG);
            for (int i = bx * 512 + tid; i < DEPTH * 4 * 128 * 128 / 2; i += G * 512) { const int e = 2 * i, t = (e >> 7) & 127, s = e & 127; const f32x2 v = *(const f32x2*)(sw + e);
                ((unsigned*)wsg)[i] = pk2(s <= t ? v.x : 0.f, (s + 1) <= t ? v.y : 0.f); } }
        for (int m = gw; m < M_TOK; m += NGW) {
            const f32x4* xr = (const f32x4*)(x_in + (size_t)m * DM) + lane; unsigned long long* o8 = (unsigned long long*)(XB + (size_t)m * DM) + lane; float q = 0.f;
#pragma unroll
            for (int j = 0; j < 4; ++j) { const f32x4 v = xr[64 * j]; q += (v.x * v.x + v.y * v.y) + (v.z * v.z + v.w * v.w); o8[64 * j] = (unsigned long long)pk2(v.x, v.y) | ((unsigned long long)pk2(v.z, v.w) << 32); }
            q = wave_sum(q);
            if (lane < 16) SS[(size_t)m * 16 + lane] = (lane == 0) ? q : 0.f;
        }
    }
    grid.sync();

#pragma unroll 1
    for (int l = 0; l < DEPTH; ++l) {
        {
            pg8::Gemm g{XB, (const bf16*)(ws + WS_WIN + l * SZ_WIN), M_TOK, PW, DM}; pg8::StaticOrder S; S.init(M_TOK, PW, G, bx);
            pg8::EpiAct<0, PW> E{PROJ, SS, QSCALE};
            pg8::gemm_phase<pg8::EpiAct<0, PW>, pg8::StaticOrder, true, true>(lds, g, S, E);
        }
        xcd_barrier(bar);
#ifndef REP_P2
#define REP_P2 1
#endif
#pragma unroll 1
        for (int rep = 0; rep < REP_P2; ++rep) {
            int tid = threadIdx.x; asm volatile("" : "+v"(tid));
            const int lane = tid & 63, wid = __builtin_amdgcn_readfirstlane(tid >> 6);
            const float* relb = args.in[3] + (size_t)l * 8 * 257;
#ifndef REP_ATT
#define REP_ATT 1
#endif
            for (int ra = 0; ra < REP_ATT; ++ra) for (int u = vcu; u < BATCH * 8 * (NCHUNK / 4); u += G) { const int cq = u % (NCHUNK / 4), bh = u / (NCHUNK / 4); attn_unit2(PROJ, MIXB, relb, bh >> 3, bh & 7, cq, lds, tid, wid, lane); }
            for (int u = bx; u < M_TOK / 64; u += G) conv_item(PROJ, MIXB, args.in[4] + (size_t)l * 3 * 256, u, tid);
            __syncthreads();
            for (int u = bx; u < M_TOK / 128; u += G)
                gate_item(PROJ, MIXB, args.in[5] + l * 256, args.in[6] + l * 256, (const bf16*)(ws + WS_WSG + l * SZ_WSG), args.in[8] + l * 512, u, lds, tid, wid, lane);
        }
        xcd_barrier(bar);
        {
            pg8::Gemm g{MIXB, (const bf16*)(ws + WS_WOUT + l * SZ_WOUT), M_TOK, DM, DM}; pg8::StaticOrder S; S.init(M_TOK, DM, G, bx);
            pg8::EpiRes E{XB, SS};
            pg8::gemm_phase<pg8::EpiRes, pg8::StaticOrder, true, true>(lds, g, S, E);
        }
        xcd_barrier(bar);
        {
            pg8::Gemm g{XB, (const bf16*)(ws + WS_WUP + l * SZ_WUP), M_TOK, DFF, DM}; pg8::StaticOrder S; S.init(M_TOK, DFF, G, bx);
            pg8::EpiAct<1, DFF> E{HDN, SS, 1.0f};
            pg8::gemm_phase<pg8::EpiAct<1, DFF>, pg8::StaticOrder, true, true>(lds, g, S, E);
        }
        xcd_barrier(bar);
        {
            pg8::Gemm g{HDN, (const bf16*)(ws + WS_WDN + l * SZ_WDN), M_TOK, DM, DFF}; pg8::StaticOrder S; S.init(M_TOK, DM, G, bx);
            pg8::EpiRes E{XB, SS};
            pg8::gemm_phase<pg8::EpiRes, pg8::StaticOrder, true, true>(lds, g, S, E);
        }
        xcd_barrier(bar);
    }
    {
        int tidf = threadIdx.x; asm volatile("" : "+v"(tidf)); const int lane = tidf & 63, wid = __builtin_amdgcn_readfirstlane(tidf >> 6);
        const int gw = vcu * NWAVES + wid, NGW = G * NWAVES; const f32x4* gp = (const f32x4*)args.in[14] + lane;
        for (int m = gw; m < M_TOK; m += NGW) {
            f32x4* xr = (f32x4*)(X + (size_t)m * DM) + lane; const u32x2* br = (const u32x2*)(XB + (size_t)m * DM) + lane; f32x4 v[4]; float q = 0.f;
#pragma unroll
            for (int j = 0; j < 4; ++j) { const u32x2 w = br[64 * j]; v[j] = (f32x4){bf_lo(w.x), bf_hi(w.x), bf_lo(w.y), bf_hi(w.y)}; q += (v[j].x * v[j].x + v[j].y * v[j].y) + (v[j].z * v[j].z + v[j].w * v[j].w); }
            const float rs = 1.0f / sqrtf(wave_sum(q) * (1.0f / DM) + EPS);
#pragma unroll
            for (int j = 0; j < 4; ++j) xr[64 * j] = v[j] * rs * gp[64 * j];
        }
    }
}

extern "C" void kernel_launch(void* const* d_in, const int* in_sizes, int n_in, void* d_out, int out_size, void* d_ws, size_t ws_size, hipStream_t stream) {
    static int grid = 0;
    if (grid == 0) {
        if (n_in != 15 || in_sizes[0] != M_TOK * DM || out_size != M_TOK * DM || ws_size < WS_END) { fprintf(stderr, "kernel_launch: unexpected shapes (n_in %d, in0 %d, out %d, ws %zu < %zu); nothing launched\n", n_in, n_in > 0 ? in_sizes[0] : -1, out_size, ws_size, (size_t)WS_END); grid = -1; return; }
        int dev = 0, cus = 0, per_cu = 0;
        if (hipGetDevice(&dev) != hipSuccess || hipDeviceGetAttribute(&cus, hipDeviceAttributeMultiprocessorCount, dev) != hipSuccess) { grid = -1; return; }
        if (hipFuncSetAttribute((const void*)trunk_fwd, hipFuncAttributeMaxDynamicSharedMemorySize, LDS_BYTES) != hipSuccess) { fprintf(stderr, "kernel_launch: hipFuncSetAttribute failed\n"); grid = -1; return; }
        if (hipOccupancyMaxActiveBlocksPerMultiprocessor(&per_cu, (const void*)trunk_fwd, NWAVES * 64, LDS_BYTES) != hipSuccess || per_cu < 1) { fprintf(stderr, "kernel_launch: occupancy query says %d blocks per CU\n", per_cu); per_cu = 1; }
        (void)hipGetLastError();
        grid = cus * per_cu;
    }
    if (grid < 0) return;
    if (hipMemsetAsync((char*)d_ws + WS_CTL, 0, CTL_BYTES, stream) != hipSuccess) { fprintf(stderr, "kernel_launch: memset failed\n"); return; }
    Args a{};
    for (int i = 0; i < 15; ++i) a.in[i] = (const float*)d_in[i];
    a.out = (float*)d_out; a.ws = (unsigned char*)d_ws;
    void* kargs[] = {&a};
    hipError_t e = hipLaunchCooperativeKernel((const void*)trunk_fwd, dim3(grid), dim3(NWAVES * 64), kargs, LDS_BYTES, stream);
    if (e != hipSuccess) fprintf(stderr, "kernel_launch: cooperative launch failed: %s (grid %d)\n", hipGetErrorString(e), grid);
}
```
